# Optimizing an MI355X kernel written in HIP

```python
import jax, jax.numpy as jnp
from jax import lax
import numpy as np

D_MODEL = 2048
BATCH = 4
SEQ = 2048
DEPTH = 2
DEC_BATCH = 8
DEC_SEQ = 32
PAST_LEN = 2048

CHUNK = 64
MIX_WIDTH = D_MODEL
GLA_WIDTH = MIX_WIDTH // 2
FOX_WIDTH = MIX_WIDTH - GLA_WIDTH
GLA_HEADS = 4
GLA_DV = GLA_WIDTH // GLA_HEADS
GLA_DK = GLA_DV // 2
GLA_RANK = 16
GLA_TAU = 16.0
FOX_HD = 128
FOX_HEADS = FOX_WIDTH // FOX_HD
FOX_QBLK = 128
D_FF = 4 * D_MODEL
EPS = 1e-6
PROJ_SIZES = (GLA_HEADS * GLA_DK, GLA_HEADS * GLA_DK, GLA_WIDTH, GLA_RANK, GLA_WIDTH,
              FOX_WIDTH, FOX_WIDTH, FOX_WIDTH, FOX_HEADS)
PROJ_WIDTH = 2 * GLA_HEADS * GLA_DK + 2 * GLA_WIDTH + GLA_RANK + 3 * FOX_WIDTH + FOX_HEADS

kernel_name = "hymba_gla_fox_stream_step"


def rmsnorm(x, g):
    xf = x.astype(jnp.float32)
    y = xf * lax.rsqrt(jnp.mean(xf * xf, axis=-1, keepdims=True) + EPS)
    return (y * g.astype(jnp.float32)).astype(x.dtype)


def project(h, w_in, w_gate_up, b_gate, b_fox_f):
    B, L, _ = h.shape
    z = jnp.einsum('bld,de->ble', h, w_in)
    idx = np.cumsum(PROJ_SIZES)[:-1].tolist()
    qg, kg, vg, glr, rg, qf, kf, vf, fl = jnp.split(z, idx, axis=-1)
    qg = qg.reshape(B, L, GLA_HEADS, GLA_DK) * (GLA_DK ** -0.5)
    kg = kg.reshape(B, L, GLA_HEADS, GLA_DK)
    vg = vg.reshape(B, L, GLA_HEADS, GLA_DV)
    g = jax.nn.log_sigmoid((jnp.einsum('blr,re->ble', glr, w_gate_up) + b_gate).astype(jnp.float32)) / GLA_TAU
    g = g.reshape(B, L, GLA_HEADS, GLA_DK)
    qf = qf.reshape(B, L, FOX_HEADS, FOX_HD)
    kf = kf.reshape(B, L, FOX_HEADS, FOX_HD)
    vf = vf.reshape(B, L, FOX_HEADS, FOX_HD)
    logf = jax.nn.log_sigmoid((fl + b_fox_f).astype(jnp.float32))
    return qg, kg, vg, g, rg, qf, kf, vf, logf


def gla_chunked(q, k, v, g, s0):
    B, L, H, DK = q.shape
    DV = v.shape[-1]
    pad = (-L) % CHUNK
    if pad:
        q, k, v, g = [jnp.pad(t, ((0, 0), (0, pad), (0, 0), (0, 0))) for t in (q, k, v, g)]
    N = (L + pad) // CHUNK

    def blocks(t):
        return t.reshape(B, N, CHUNK, H, t.shape[-1]).transpose(1, 0, 3, 2, 4)

    qb, kb, vb, gb = blocks(q), blocks(k), blocks(v), blocks(g)
    dt = q.dtype
    b = jnp.cumsum(gb, axis=3)
    b_last = b[:, :, :, -1:, :]
    q_i = (qb * jnp.exp(b)).astype(dt)
    k_i = (kb * jnp.exp(-b)).astype(dt)
    k_e = (kb * jnp.exp(b_last - b)).astype(dt)
    causal = jnp.tril(jnp.ones((CHUNK, CHUNK), dtype=bool))
    att = jnp.where(causal, jnp.einsum('nbhcd,nbhsd->nbhcs', q_i, k_i), 0)
    o_intra = jnp.einsum('nbhcs,nbhsv->nbhcv', att.astype(dt), vb)
    kv = jnp.einsum('nbhsd,nbhsv->nbhdv', k_e, vb).astype(s0.dtype)
    decay = jnp.exp(b_last[:, :, :, 0, :]).astype(s0.dtype)

    def step(S, inp):
        dec, kvn = inp
        return dec[..., None] * S + kvn, S

    s_final, s_starts = lax.scan(step, s0, (decay, kv))
    o_inter = jnp.einsum('nbhcd,nbhdv->nbhcv', q_i, s_starts.astype(dt))
    o = (o_intra + o_inter).transpose(1, 0, 3, 2, 4).reshape(B, N * CHUNK, H, DV)[:, :L]
    return o, s_final


def fox_attend(q, k, v, c_q, c_k, q_pos, k_pos):
    s = jnp.einsum('bqhd,bkhd->bhqk', q, k).astype(jnp.float32) * (FOX_HD ** -0.5)
    s = s + c_q.transpose(0, 2, 1)[:, :, :, None] - c_k.transpose(0, 2, 1)[:, :, None, :]
    s = jnp.where(k_pos[None, :] <= q_pos[:, None], s, -jnp.inf)
    p = jax.nn.softmax(s, axis=-1).astype(v.dtype)
    return jnp.einsum('bhqk,bkhd->bqhd', p, v)


def fox_prompt(q, k, v, logf):
    L = q.shape[1]
    c = jnp.cumsum(logf, axis=1)
    pos = jnp.arange(L)
    outs = []
    for i in range(L // FOX_QBLK):
        lo, hi = i * FOX_QBLK, (i + 1) * FOX_QBLK
        outs.append(fox_attend(q[:, lo:hi], k[:, :hi], v[:, :hi], c[:, lo:hi], c[:, :hi], pos[lo:hi], pos[:hi]))
    return jnp.concatenate(outs, axis=1)


def merge_heads(o_gla, r_g, o_fox, g_onorm, w_out):
    B, L = o_gla.shape[:2]
    o_gla = rmsnorm(o_gla, g_onorm.reshape(GLA_HEADS, GLA_DV)).reshape(B, L, GLA_WIDTH) * jax.nn.silu(r_g)
    o = jnp.concatenate([o_gla, o_fox.reshape(B, L, FOX_WIDTH)], axis=-1)
    return jnp.einsum('ble,ed->bld', o, w_out)


def sq_relu_mlp(h, w_up, w_down):
    u = jax.nn.relu(jnp.einsum('bld,df->blf', h, w_up))
    return jnp.einsum('blf,fd->bld', u * u, w_down)


def setup_inputs(seed: int = 0) -> dict:
    key = jax.random.key(seed)
    ks = jax.random.split(key, 20)

    def nrm(k, shape, scale=1.0):
        return jax.random.normal(k, shape, jnp.float32) * scale

    def gain(k, shape):
        return 1.0 + 0.05 * jax.random.normal(k, shape, jnp.float32)

    return {
        "x_prompt": nrm(ks[0], (BATCH, SEQ, D_MODEL)),
        "x_sample": nrm(ks[1], (DEC_BATCH, DEC_SEQ, D_MODEL)),
        "cache_fox_k": nrm(ks[2], (DEPTH, DEC_BATCH, PAST_LEN, FOX_HEADS, FOX_HD)),
        "cache_fox_v": nrm(ks[3], (DEPTH, DEC_BATCH, PAST_LEN, FOX_HEADS, FOX_HD)),
        "cache_fox_logf": jax.nn.log_sigmoid(nrm(ks[4], (DEPTH, DEC_BATCH, PAST_LEN, FOX_HEADS)) + 2.0),
        "state_gla": nrm(ks[5], (DEPTH, DEC_BATCH, GLA_HEADS, GLA_DK, GLA_DV), 0.5),
        "g_mix_pre": gain(ks[6], (DEPTH, D_MODEL)),
        "w_in": nrm(ks[7], (DEPTH, D_MODEL, PROJ_WIDTH), D_MODEL ** -0.5),
        "w_gla_gate_up": nrm(ks[8], (DEPTH, GLA_RANK, GLA_HEADS * GLA_DK), GLA_RANK ** -0.5),
        "b_gla_gate": nrm(ks[9], (DEPTH, GLA_HEADS * GLA_DK), 0.1),
        "b_fox_f": nrm(ks[10], (DEPTH, FOX_HEADS), 0.1),
        "g_gla_onorm": gain(ks[11], (DEPTH, GLA_WIDTH)),
        "w_out": nrm(ks[12], (DEPTH, MIX_WIDTH, D_MODEL), MIX_WIDTH ** -0.5),
        "g_mix_post": gain(ks[13], (DEPTH, D_MODEL)),
        "g_mlp_pre": gain(ks[14], (DEPTH, D_MODEL)),
        "w_mlp_up": nrm(ks[15], (DEPTH, D_MODEL, D_FF), D_MODEL ** -0.5),
        "w_mlp_down": nrm(ks[16], (DEPTH, D_FF, D_MODEL), D_FF ** -0.5),
        "g_mlp_post": gain(ks[17], (DEPTH, D_MODEL)),
    }


def reference(x_prompt, x_sample, cache_fox_k, cache_fox_v, cache_fox_logf, state_gla,
              g_mix_pre, w_in, w_gla_gate_up, b_gla_gate, b_fox_f, g_gla_onorm, w_out,
              g_mix_post, g_mlp_pre, w_mlp_up, w_mlp_down, g_mlp_post):
    past_len = cache_fox_k.shape[2]
    yp, ys = x_prompt, x_sample
    kp, vp, fp, sp = [], [], [], []
    ksm, vsm, fsm, ssm = [], [], [], []
    for l in range(DEPTH):
        h = rmsnorm(yp, g_mix_pre[l])
        qg, kg, vg, g, rg, qf, kf, vf, logf = project(h, w_in[l], w_gla_gate_up[l], b_gla_gate[l], b_fox_f[l])
        s0 = jnp.zeros((yp.shape[0], GLA_HEADS, GLA_DK, GLA_DV), yp.dtype)
        o_gla, s_new = gla_chunked(qg, kg, vg, g, s0)
        o_fox = fox_prompt(qf, kf, vf, logf)
        yp = yp + rmsnorm(merge_heads(o_gla, rg, o_fox, g_gla_onorm[l], w_out[l]), g_mix_post[l])
        yp = yp + rmsnorm(sq_relu_mlp(rmsnorm(yp, g_mlp_pre[l]), w_mlp_up[l], w_mlp_down[l]), g_mlp_post[l])
        kp.append(kf); vp.append(vf); fp.append(logf); sp.append(s_new)

        h = rmsnorm(ys, g_mix_pre[l])
        qg, kg, vg, g, rg, qf, kf, vf, logf = project(h, w_in[l], w_gla_gate_up[l], b_gla_gate[l], b_fox_f[l])
        o_gla, s_new = gla_chunked(qg, kg, vg, g, state_gla[l])
        T = qf.shape[1]
        k_all = jnp.concatenate([cache_fox_k[l], kf], axis=1)
        v_all = jnp.concatenate([cache_fox_v[l], vf], axis=1)
        c_all = jnp.cumsum(jnp.concatenate([cache_fox_logf[l].astype(jnp.float32), logf], axis=1), axis=1)
        o_fox = fox_attend(qf, k_all, v_all, c_all[:, past_len:], c_all,
                           past_len + jnp.arange(T), jnp.arange(past_len + T))
        ys = ys + rmsnorm(merge_heads(o_gla, rg, o_fox, g_gla_onorm[l], w_out[l]), g_mix_post[l])
        ys = ys + rmsnorm(sq_relu_mlp(rmsnorm(ys, g_mlp_pre[l]), w_mlp_up[l], w_mlp_down[l]), g_mlp_post[l])
        ksm.append(kf); vsm.append(vf); fsm.append(logf); ssm.append(s_new)

    new_fox_k_prompt = jnp.stack(kp)
    new_fox_v_prompt = jnp.stack(vp)
    new_fox_logf_prompt = jnp.stack(fp)
    new_state_gla_prompt = jnp.stack(sp)
    new_fox_k_sample = jnp.stack(ksm)
    new_fox_v_sample = jnp.stack(vsm)
    new_fox_logf_sample = jnp.stack(fsm)
    new_state_gla_sample = jnp.stack(ssm)
    return (yp, ys, new_fox_k_prompt, new_fox_v_prompt, new_fox_logf_prompt, new_state_gla_prompt,
            new_fox_k_sample, new_fox_v_sample, new_fox_logf_sample, new_state_gla_sample)
```

```cpp
#include <hip/hip_runtime.h>
#include <hip/hip_cooperative_groups.h>
#include <cstdio>
namespace cg = cooperative_groups;
#ifndef MEGA
#define MEGA 1
#endif
__device__ __forceinline__ int tid_opaque() { int t = threadIdx.x; asm volatile("" : "+v"(t)); return t; }
namespace pg8 {
#define PG8_LAS __attribute__((address_space(3)))
typedef unsigned short bf16_t;
typedef short bf16x8 __attribute__((ext_vector_type(8)));
typedef float f32x4 __attribute__((ext_vector_type(4)));
typedef unsigned u32x4 __attribute__((ext_vector_type(4)));
constexpr int BM = 256, BK = 64, HALF = 128, HTB = HALF * BK * 2  , STAGE_BYTES = 8 * HTB, NXCD = 8, WGM = 8;

__host__ __device__ __forceinline__ int lds_byte(int r, int c) { const int st = (r >> 4) * 2 + (c >> 5), rr = r & 15, cc = c & 31, ob = rr * 64 + cc * 2; return st * 1024 + (ob ^ (((ob >> 9) & 1) << 5)); }
__host__ __device__ __forceinline__ void stage_rc(int b, int& R, int& C) { const int st = b / 1024, sb = b % 1024, swz = sb ^ (((sb >> 9) & 1) << 5); R = (st >> 1) * 16 + swz / 64; C = (st & 1) * 32 + (swz % 64) / 2; }
__host__ __device__ __forceinline__ int perm32(int rho) { const int n = rho >> 4, i = rho & 15; return 8 * (i >> 2) + 4 * n + (i & 3); }

struct Unit { int pm, pn; };
struct Gemm { const bf16_t* A; const bf16_t* Bt; int M, N, K; };

struct StaticOrder {
    int nM, nN, nwg, G, c;
    __host__ __device__ void init(int M, int N, int G_, int c_) { nM = M / BM; nN = N / BM; nwg = nM * nN; G = G_; c = c_; }
    __host__ __device__ bool next(int i, Unit& u) const {
        const long L = (long)i * G + c; if (L >= nwg) return false;
        int wgid = (int)L; { const int q = nwg / NXCD, r = nwg % NXCD, xcd = wgid % NXCD, off = wgid / NXCD; wgid = (xcd < r ? xcd * (q + 1) : r * (q + 1) + (xcd - r) * q) + off; }
        const int nig = WGM * nN, gid = wgid / nig, fm = gid * WGM, gsz = (nM - fm) < WGM ? (nM - fm) : WGM;
        u.pm = fm + ((wgid % nig) % gsz); u.pn = (wgid % nig) / gsz; return true;
    }
    __device__ __forceinline__ void a_ready(const Unit&) const {}
    __device__ __forceinline__ void done(const Unit&) const {}
};

template <class Epi, class Sched, bool STAMP = false>
__device__ __forceinline__ void gemm_phase(PG8_LAS unsigned char* lds, const Gemm g, const Sched& S, const Epi& E, unsigned long long* stamps) {
    const int tid = tid_opaque(), wid = __builtin_amdgcn_readfirstlane(tid >> 6), lane = tid & 63, wr = wid >> 2, wc = wid & 3, fr = lane & 15, fq = lane >> 4;
    const int K = g.K, nt = K / BK;
    int ts_lo = 0, ts_hi = 0, nts = 0; const unsigned long long rt_entry = STAMP ? (unsigned long long)wall_clock64() : 0ull;
#define PG8_STAMP() do { if (STAMP && wid == 0 && nts < 64) { const unsigned long long _c = (unsigned long long)clock64(); \
        ts_lo = (lane == nts) ? (int)(unsigned)_c : ts_lo; ts_hi = (lane == nts) ? (int)(unsigned)(_c >> 32) : ts_hi; ++nts; } } while (0)
    PG8_STAMP();
    unsigned voffA[2], voffB[2];
#pragma unroll
    for (int i = 0; i < 2; ++i) { int R, C; stage_rc(tid * 16 + i * 8192, R, C); const int Rb = Epi::PERM ? ((R & ~31) + perm32(R & 31)) : R;
        voffA[i] = (unsigned)(R * K + C) * 2u; voffB[i] = (unsigned)(Rb * K + C) * 2u; }
    const size_t kstep = (size_t)(BK * 2);
    const size_t hstep = (size_t)HALF * K * 2;
    const size_t tstep = 2 * hstep;
    const unsigned ldsw = (unsigned)wid * 1024u;
    const int aoff = lds_byte(wr * 64 + fr, fq * 8), boff = lds_byte(wc * 32 + fr, fq * 8);
#define PG8_SA(b, h) (((b) * 2 + (h)) * HTB)
#define PG8_SB(b, h) ((4 + (b) * 2 + (h)) * HTB)
#define PG8_STAGE(bufoff, gbase, voff) do { _Pragma("unroll") for (int _i = 0; _i < 2; ++_i) \
        __builtin_amdgcn_global_load_lds((const unsigned*)((const char*)(gbase) + (voff)[_i]), (PG8_LAS unsigned*)(lds + (bufoff) + ldsw + _i * 8192), 16, 0, 0); } while (0)
#define PG8_LDA(dst, b, h) do { _Pragma("unroll") for (int m = 0; m < 4; ++m) _Pragma("unroll") for (int k = 0; k < 2; ++k) dst[m][k] = *(const PG8_LAS bf16x8*)(lds + PG8_SA(b, h) + aoff + m * 2048 + k * 1024); } while (0)
#define PG8_LDB(dst, b, h) do { _Pragma("unroll") for (int n = 0; n < 2; ++n) _Pragma("unroll") for (int k = 0; k < 2; ++k) dst[n][k] = *(const PG8_LAS bf16x8*)(lds + PG8_SB(b, h) + boff + n * 2048 + k * 1024); } while (0)
#define PG8_MMA(ai, bj, At, Bt) do { __builtin_amdgcn_s_setprio(1); _Pragma("unroll") for (int m = 0; m < 4; ++m) _Pragma("unroll") for (int n = 0; n < 2; ++n) _Pragma("unroll") for (int k = 0; k < 2; ++k) \
        acc[ai][bj][m][n] = __builtin_amdgcn_mfma_f32_16x16x32_bf16(Bt[n][k], At[m][k], acc[ai][bj][m][n], 0, 0, 0); __builtin_amdgcn_s_setprio(0); } while (0)
#define PG8_WAIT_V(n) asm volatile("s_waitcnt vmcnt(" #n ")" ::: "memory")
#define PG8_WAIT_L(n) asm volatile("s_waitcnt lgkmcnt(" #n ")" ::: "memory")
#define PG8_BAR __builtin_amdgcn_s_barrier()
#define PG8_SCHED __builtin_amdgcn_sched_barrier(0)
    Unit cur, nxt; int ui = 0;
    if (!S.next(0, cur)) return;
    f32x4 acc[2][2][4][2];
#pragma unroll
    for (int a = 0; a < 2; ++a)
#pragma unroll
        for (int b = 0; b < 2; ++b)
#pragma unroll
            for (int m = 0; m < 4; ++m)
#pragma unroll
                for (int n = 0; n < 2; ++n) acc[a][b][m][n] = (f32x4){0.f, 0.f, 0.f, 0.f};
    bf16x8 At[4][2], B0[2][2], B1[2][2];
    const char* cA = (const char*)g.A + (size_t)cur.pm * tstep; const char* cB = (const char*)g.Bt + (size_t)cur.pn * tstep;
    S.a_ready(cur);
    PG8_STAGE(PG8_SB(0, 0), cB, voffB); PG8_STAGE(PG8_SA(0, 0), cA, voffA); PG8_STAGE(PG8_SB(0, 1), cB + hstep, voffB); PG8_STAGE(PG8_SA(0, 1), cA + hstep, voffA);
    if (wr == 1) PG8_BAR;
    PG8_WAIT_V(4); PG8_BAR;
    PG8_STAGE(PG8_SB(1, 0), cB + kstep, voffB); PG8_STAGE(PG8_SA(1, 0), cA + kstep, voffA); PG8_STAGE(PG8_SB(1, 1), cB + hstep + kstep, voffB);
    PG8_WAIT_V(6); PG8_BAR;
    PG8_STAMP();
    for (;;) {
        const bool has_next = S.next(ui + 1, nxt);
        const char* nA = has_next ? (const char*)g.A + (size_t)nxt.pm * tstep : cA; const char* nB = has_next ? (const char*)g.Bt + (size_t)nxt.pn * tstep : cB;
        for (int t = 0; t < nt; t += 2) {
            const bool last = (t == nt - 2);
            const char* a1 = cA + (size_t)(t + 1) * kstep;
            const char* a2 = last ? nA : cA + (size_t)(t + 2) * kstep; const char* b2 = last ? nB : cB + (size_t)(t + 2) * kstep;
            const char* a3 = a2 + kstep; const char* b3 = b2 + kstep;
            if (last && has_next) S.a_ready(nxt);
            PG8_LDB(B0, 0, 0); PG8_SCHED; PG8_LDA(At, 0, 0); PG8_STAGE(PG8_SA(1, 1), a1 + hstep, voffA);
            PG8_WAIT_L(8); PG8_BAR; PG8_WAIT_L(0); PG8_MMA(0, 0, At, B0); PG8_BAR; PG8_SCHED;
            PG8_LDB(B1, 0, 1); PG8_STAGE(PG8_SB(0, 0), b2, voffB);
            PG8_BAR; PG8_WAIT_L(0); PG8_MMA(0, 1, At, B1); PG8_BAR;
            PG8_LDA(At, 0, 1); PG8_STAGE(PG8_SA(0, 0), a2, voffA);
            PG8_BAR; PG8_WAIT_L(0); PG8_MMA(1, 0, At, B0); PG8_BAR; PG8_SCHED;
            PG8_STAGE(PG8_SB(0, 1), b2 + hstep, voffB);
            PG8_WAIT_V(6); PG8_BAR; PG8_MMA(1, 1, At, B1); PG8_BAR;
            PG8_LDB(B0, 1, 0); PG8_SCHED; PG8_LDA(At, 1, 0); PG8_STAGE(PG8_SA(0, 1), a2 + hstep, voffA);
            PG8_WAIT_L(8); PG8_BAR; PG8_WAIT_L(0); PG8_MMA(0, 0, At, B0); PG8_BAR; PG8_SCHED;
            PG8_LDB(B1, 1, 1); PG8_STAGE(PG8_SB(1, 0), b3, voffB);
            PG8_BAR; PG8_WAIT_L(0); PG8_MMA(0, 1, At, B1); PG8_BAR;
            PG8_LDA(At, 1, 1); PG8_STAGE(PG8_SA(1, 0), a3, voffA);
            PG8_BAR; PG8_WAIT_L(0); PG8_MMA(1, 0, At, B0); PG8_BAR; PG8_SCHED;
            PG8_STAGE(PG8_SB(1, 1), b3 + hstep, voffB);
            PG8_WAIT_V(6); PG8_BAR; PG8_MMA(1, 1, At, B1); PG8_BAR;
        }
        PG8_STAMP();
        if constexpr (!Epi::AFTER_DRAIN) { E(acc, cur, wr, wc, fr, fq); S.done(cur); }
        PG8_STAMP();
        if (!has_next) break;
#pragma unroll
        for (int a = 0; a < 2; ++a)
#pragma unroll
            for (int b = 0; b < 2; ++b)
#pragma unroll
                for (int m = 0; m < 4; ++m)
#pragma unroll
                    for (int n = 0; n < 2; ++n) acc[a][b][m][n] = (f32x4){0.f, 0.f, 0.f, 0.f};
        cur = nxt; cA = nA; cB = nB; ++ui;
    }
    PG8_WAIT_V(0);
    if (wr == 0) PG8_BAR;
    PG8_BAR;
    if constexpr (Epi::AFTER_DRAIN) { E.fused(acc, cur, wr, wc, fr, fq, lds, wid, lane); S.done(cur); }
    PG8_STAMP();
    if (STAMP && wid == 0) { stamps[lane] = lane < nts ? (((unsigned long long)(unsigned)ts_hi << 32) | (unsigned)ts_lo) : 0ull;
        if (lane == 62) stamps[62] = rt_entry; if (lane == 63) stamps[63] = (unsigned long long)wall_clock64(); }
#undef PG8_STAMP
#undef PG8_SA
#undef PG8_SB
#undef PG8_STAGE
#undef PG8_LDA
#undef PG8_LDB
#undef PG8_MMA
#undef PG8_WAIT_V
#undef PG8_WAIT_L
#undef PG8_BAR
#undef PG8_SCHED
}
}

using pg8::bf16_t; using pg8::bf16x8; using pg8::f32x4; using pg8::u32x4;
typedef short s16x4 __attribute__((ext_vector_type(4)));
typedef float f32x16 __attribute__((ext_vector_type(16)));
typedef unsigned u32x2 __attribute__((ext_vector_type(2)));
#define DI __device__ __forceinline__
#define MFMA32(a, b, c) __builtin_amdgcn_mfma_f32_32x32x16_bf16((a), (b), (c), 0, 0, 0)

constexpr int NP = 8192, NS = 256, MT = 8448, DM = 2048, NZ = 6144, NIN = 6400, DFF = 8192;
constexpr float EPS = 1e-6f, LOG2E = 1.4426950408889634f;
constexpr int LDS_BYTES = 154112;
constexpr int LDS_ITEM_OFF = 153792;
constexpr size_t O_YP = 0, O_YS = 16777216, O_KP = 17301504, O_VP = 34078720, O_LFP = 50855936, O_STP = 50987008,
                 O_KS = 52035584, O_VS = 52559872, O_LFS = 53084160, O_STS = 53088256;

struct Params {
    const float *x_prompt, *x_sample, *cache_k, *cache_v, *cache_logf, *state_gla, *g_mix_pre, *w_in, *w_gate_up, *b_gate, *b_fox_f,
                *g_onorm, *w_out, *g_mix_post, *g_mlp_pre, *w_up, *w_down, *g_mlp_post;
    float* out;
    bf16_t *WinT, *WoutT, *WupT, *WdownT, *H, *MRG, *Z, *U;
    float *EX, *RAW, *OG, *SSQ;
    unsigned* ctr;
};

DI unsigned pk2(float a, float b) { typedef __bf16 v2 __attribute__((ext_vector_type(2))); v2 v; v[0] = (__bf16)a; v[1] = (__bf16)b; return __builtin_bit_cast(unsigned, v); }
DI bf16_t f2bf(float a) { return __builtin_bit_cast(unsigned short, (__bf16)a); }
DI float bf2f(unsigned u) { return __uint_as_float(u << 16); }
DI float bflo(unsigned u) { return __uint_as_float(u << 16); }
DI float bfhi(unsigned u) { return __uint_as_float(u & 0xffff0000u); }
DI float logsig(float x) { return fminf(x, 0.f) - log1pf(__expf(-fabsf(x))); }
DI int crow(int reg, int h) { return (reg & 3) + 8 * (reg >> 2) + 4 * h; }
DI float wave_sum(float v) {
#pragma unroll
    for (int o = 32; o >= 1; o >>= 1) v += __shfl_xor(v, o);
    return v;
}

struct EpiIn {
    static constexpr bool PERM = true, AFTER_DRAIN = false;
    bf16_t* Z; float* EX; float *outk_p, *outv_p, *outk_s, *outv_s;
    DI void operator()(const f32x4 (&acc)[2][2][4][2], const pg8::Unit& u, int wr, int wc, int fr, int fq) const {
        const int row0 = u.pm * 256 + wr * 64 + fr, pn = u.pn;
        const float sc = pn < 2 ? 0.08838834764831845f : 1.0f;
#pragma unroll
        for (int ai = 0; ai < 2; ++ai)
#pragma unroll
            for (int m = 0; m < 4; ++m) {
                const int row = row0 + ai * 128 + m * 16;
#pragma unroll
                for (int bj = 0; bj < 2; ++bj) {
                    const int cc = bj * 128 + wc * 32 + 8 * fq;
                    const f32x4 v0 = acc[ai][bj][m][0], v1 = acc[ai][bj][m][1];
                    if (pn < 24) {
                        u32x4 pk; pk[0] = pk2(v0[0] * sc, v0[1] * sc); pk[1] = pk2(v0[2] * sc, v0[3] * sc); pk[2] = pk2(v1[0] * sc, v1[1] * sc); pk[3] = pk2(v1[2] * sc, v1[3] * sc);
                        *(u32x4*)(Z + (size_t)row * NZ + pn * 256 + cc) = pk;
                        if (pn >= 16) {
                            const bool isk = pn < 20; const int gc = (pn - (isk ? 16 : 20)) * 256 + cc;
                            float* dst = row < NP ? (isk ? outk_p : outv_p) + (size_t)row * 1024 + gc : (isk ? outk_s : outv_s) + (size_t)(row - NP) * 1024 + gc;
                            *(f32x4*)dst = v0; *(f32x4*)(dst + 4) = v1;
                        }
                    } else if (cc < 24) {
                        float* ex = EX + (size_t)row * 32 + cc;
                        *(f32x4*)ex = v0; *(f32x4*)(ex + 4) = v1;
                    }
                }
            }
    }
};
struct EpiRaw {
    static constexpr bool PERM = true, AFTER_DRAIN = false;
    float* C;
    DI void operator()(const f32x4 (&acc)[2][2][4][2], const pg8::Unit& u, int wr, int wc, int fr, int fq) const {
        const int row0 = u.pm * 256 + wr * 64 + fr, col0 = u.pn * 256 + wc * 32 + 8 * fq;
#pragma unroll
        for (int ai = 0; ai < 2; ++ai)
#pragma unroll
            for (int m = 0; m < 4; ++m) {
                float* rp = C + (size_t)(row0 + ai * 128 + m * 16) * DM + col0;
#pragma unroll
                for (int bj = 0; bj < 2; ++bj) { *(f32x4*)(rp + bj * 128) = acc[ai][bj][m][0]; *(f32x4*)(rp + bj * 128 + 4) = acc[ai][bj][m][1]; }
            }
    }
};
struct EpiUp {
    static constexpr bool PERM = true, AFTER_DRAIN = false;
    bf16_t* U;
    DI void operator()(const f32x4 (&acc)[2][2][4][2], const pg8::Unit& u, int wr, int wc, int fr, int fq) const {
        const int row0 = u.pm * 256 + wr * 64 + fr, col0 = u.pn * 256 + wc * 32 + 8 * fq;
#pragma unroll
        for (int ai = 0; ai < 2; ++ai)
#pragma unroll
            for (int m = 0; m < 4; ++m) {
                bf16_t* rp = U + (size_t)(row0 + ai * 128 + m * 16) * DFF + col0;
#pragma unroll
                for (int bj = 0; bj < 2; ++bj) {
                    f32x4 a = acc[ai][bj][m][0], b = acc[ai][bj][m][1];
#pragma unroll
                    for (int e = 0; e < 4; ++e) { a[e] = fmaxf(a[e], 0.f); a[e] *= a[e]; b[e] = fmaxf(b[e], 0.f); b[e] *= b[e]; }
                    u32x4 pk; pk[0] = pk2(a[0], a[1]); pk[1] = pk2(a[2], a[3]); pk[2] = pk2(b[0], b[1]); pk[3] = pk2(b[2], b[3]);
                    *(u32x4*)(rp + bj * 128) = pk;
                }
            }
    }
};

template <class Epi>
DI void run_gemm(char* shm, const bf16_t* A, const bf16_t* Bt, int M, int N, int K, const Epi& E) {
    pg8::Gemm g; g.A = A; g.Bt = Bt; g.M = M; g.N = N; g.K = K;
    pg8::StaticOrder S; S.init(M, N, (int)gridDim.x, (int)blockIdx.x);
    pg8::gemm_phase<Epi, pg8::StaticOrder, false>((PG8_LAS unsigned char*)shm, g, S, E, nullptr);
}

DI void transpose_tile(const float* src, int ld, int nsrc_mode, bf16_t* dst, int Kd, int k0, int n0, float* tile) {
    const int tid = tid_opaque();
    {
        const int j = tid & 63, i0 = tid >> 6; const int n = n0 + j; int sc;
        if (nsrc_mode == 0) sc = n;
        else { if (n < 2048) sc = n; else if (n < 6144) sc = n + 16; else if (n < 6160) sc = n - 6144 + 2048; else if (n < 6168) sc = n; else sc = -1; }
#pragma unroll
        for (int s = 0; s < 8; ++s) { const int i = i0 + 8 * s; tile[i * 65 + j] = sc >= 0 ? src[(size_t)(k0 + i) * ld + sc] : 0.f; }
    }
    __syncthreads();
    {
        const int jj = tid >> 3, i8 = (tid & 7) * 8; float v[8];
#pragma unroll
        for (int e = 0; e < 8; ++e) v[e] = tile[(i8 + e) * 65 + jj];
        u32x4 pk; pk[0] = pk2(v[0], v[1]); pk[1] = pk2(v[2], v[3]); pk[2] = pk2(v[4], v[5]); pk[3] = pk2(v[6], v[7]);
        *(u32x4*)(dst + (size_t)(n0 + jj) * Kd + k0 + i8) = pk;
    }
    __syncthreads();
}

DI void norm_rows(const float* xin_p, const float* xin_s, const float* raw, const float* gpost, const float* gnext, float* yout_p, float* yout_s, bf16_t* H) {
    const int lane = tid_opaque() & 63, wid = tid_opaque() >> 6;
    for (int row = blockIdx.x * 8 + wid; row < MT; row += gridDim.x * 8) {
        const float* xi = row < NP ? xin_p + (size_t)row * DM : xin_s + (size_t)(row - NP) * DM;
        f32x4 xv[8];
#pragma unroll
        for (int i = 0; i < 8; ++i) xv[i] = *(const f32x4*)(xi + (i * 64 + lane) * 4);
        if (raw) {
            f32x4 rv[8]; float ss = 0.f;
#pragma unroll
            for (int i = 0; i < 8; ++i) { rv[i] = *(const f32x4*)(raw + (size_t)row * DM + (i * 64 + lane) * 4); ss += rv[i][0] * rv[i][0] + rv[i][1] * rv[i][1] + rv[i][2] * rv[i][2] + rv[i][3] * rv[i][3]; }
            ss = wave_sum(ss); const float rs = rsqrtf(ss * (1.0f / DM) + EPS);
#pragma unroll
            for (int i = 0; i < 8; ++i) { const f32x4 gp = *(const f32x4*)(gpost + (i * 64 + lane) * 4); xv[i] += rv[i] * rs * gp; }
            float* yo = row < NP ? yout_p + (size_t)row * DM : yout_s + (size_t)(row - NP) * DM;
#pragma unroll
            for (int i = 0; i < 8; ++i) *(f32x4*)(yo + (i * 64 + lane) * 4) = xv[i];
        }
        if (gnext) {
            float ss = 0.f;
#pragma unroll
            for (int i = 0; i < 8; ++i) ss += xv[i][0] * xv[i][0] + xv[i][1] * xv[i][1] + xv[i][2] * xv[i][2] + xv[i][3] * xv[i][3];
            ss = wave_sum(ss); const float rs = rsqrtf(ss * (1.0f / DM) + EPS);
#pragma unroll
            for (int i = 0; i < 8; ++i) {
                const f32x4 gn = *(const f32x4*)(gnext + (i * 64 + lane) * 4); const f32x4 hv = xv[i] * rs * gn;
                u32x2 pk; pk[0] = pk2(hv[0], hv[1]); pk[1] = pk2(hv[2], hv[3]);
                *(u32x2*)(H + (size_t)row * DM + (i * 64 + lane) * 4) = pk;
            }
        }
    }
}

DI void phase0(const Params& p, char* shm) {
    if (blockIdx.x == 0 && tid_opaque() < 16) p.ctr[tid_opaque()] = 0u;
    float* tile = (float*)shm;
    constexpr int PER_L = 3200 + 1024 + 4096 + 4096;
    for (int t = blockIdx.x; t < 2 * PER_L; t += gridDim.x) {
        const int l = t / PER_L; int u = t % PER_L;
        if (u < 3200) { const int kt = u / 100, nt = u % 100; transpose_tile(p.w_in + (size_t)l * DM * 6168, 6168, 1, p.WinT + (size_t)l * NIN * DM, DM, kt * 64, nt * 64, tile); }
        else if ((u -= 3200) < 1024) { const int kt = u / 32, nt = u % 32; transpose_tile(p.w_out + (size_t)l * DM * DM, DM, 0, p.WoutT + (size_t)l * DM * DM, DM, kt * 64, nt * 64, tile); }
        else if ((u -= 1024) < 4096) { const int kt = u / 128, nt = u % 128; transpose_tile(p.w_up + (size_t)l * DM * DFF, DFF, 0, p.WupT + (size_t)l * DFF * DM, DM, kt * 64, nt * 64, tile); }
        else { u -= 4096; const int kt = u / 32, nt = u % 32; transpose_tile(p.w_down + (size_t)l * DFF * DM, DM, 0, p.WdownT + (size_t)l * DM * DFF, DFF, kt * 64, nt * 64, tile); }
    }
    norm_rows(p.x_prompt, p.x_sample, nullptr, nullptr, p.g_mix_pre, nullptr, nullptr, p.H);
}

template <class F>
DI void block_cumsum(int n, F load, float* cs, float* wt) {
    const int tid = tid_opaque(), lane = tid & 63, wid = tid >> 6;
    float v[5]; float s = 0.f;
#pragma unroll
    for (int j = 0; j < 5; ++j) { const int idx = tid * 5 + j; v[j] = idx < n ? load(idx) : 0.f; s += v[j]; }
    float inc = s;
#pragma unroll
    for (int o = 1; o < 64; o <<= 1) { const float t = __shfl_up(inc, o); if (lane >= o) inc += t; }
    if (lane == 63) wt[wid] = inc;
    __syncthreads();
    float run = inc - s;
    for (int w = 0; w < wid; ++w) run += wt[w];
#pragma unroll
    for (int j = 0; j < 5; ++j) { const int idx = tid * 5 + j; run += v[j]; if (idx < n) cs[idx] = run * LOG2E; }
    __syncthreads();
}

template <int NKT>
DI void fox_tile(const bf16_t* Ks, int ldk, const bf16_t* Vt, int ldv, const float* csl, int kpos0, int qpos, float cql,
                 const bf16x8 (&qf)[8], f32x16 (&o)[4], float& m, float& l, int r, int hh) {
    constexpr float SC2 = 0.08838834764831845f * LOG2E;
    f32x16 x[NKT];
#pragma unroll
    for (int t2 = 0; t2 < NKT; ++t2) {
#pragma unroll
        for (int i = 0; i < 16; ++i) x[t2][i] = 0.f;
#pragma unroll
        for (int ks = 0; ks < 8; ++ks) { const bf16x8 a = *(const bf16x8*)(Ks + (t2 * 32 + r) * ldk + 16 * ks + 8 * hh); x[t2] = MFMA32(a, qf[ks], x[t2]); }
    }
    float mx = -1e30f;
#pragma unroll
    for (int t2 = 0; t2 < NKT; ++t2)
#pragma unroll
        for (int i = 0; i < 16; ++i) {
            const int kl = t2 * 32 + crow(i, hh);
            float v = fmaf(x[t2][i], SC2, cql - csl[kl]);
            v = (kpos0 + kl <= qpos) ? v : -1e30f;
            x[t2][i] = v; mx = fmaxf(mx, v);
        }
    mx = fmaxf(mx, __shfl_xor(mx, 32));
    const float mn = fmaxf(m, mx), alpha = __builtin_amdgcn_exp2f(m - mn);
    m = mn;
    float ls = 0.f;
#pragma unroll
    for (int t2 = 0; t2 < NKT; ++t2)
#pragma unroll
        for (int i = 0; i < 16; ++i) { const float pv = __builtin_amdgcn_exp2f(x[t2][i] - mn); x[t2][i] = pv; ls += pv; }
    l = l * alpha + ls;
#pragma unroll
    for (int dt = 0; dt < 4; ++dt)
#pragma unroll
        for (int i = 0; i < 16; ++i) o[dt][i] *= alpha;
#pragma unroll
    for (int t2 = 0; t2 < NKT; ++t2)
#pragma unroll
        for (int s = 0; s < 2; ++s) {
            u32x4 pp; pp[0] = pk2(x[t2][8 * s + 0], x[t2][8 * s + 1]); pp[1] = pk2(x[t2][8 * s + 2], x[t2][8 * s + 3]);
            pp[2] = pk2(x[t2][8 * s + 4], x[t2][8 * s + 5]); pp[3] = pk2(x[t2][8 * s + 6], x[t2][8 * s + 7]);
            const bf16x8 pf = __builtin_bit_cast(bf16x8, pp);
#pragma unroll
            for (int dt = 0; dt < 4; ++dt) {
                const bf16_t* vp = Vt + (dt * 32 + r) * ldv + t2 * 32 + 16 * s + 4 * hh;
                const s16x4 lo = *(const s16x4*)vp, hi = *(const s16x4*)(vp + 8);
                const bf16x8 a = __builtin_shufflevector(lo, hi, 0, 1, 2, 3, 4, 5, 6, 7);
                o[dt] = MFMA32(a, pf, o[dt]);
            }
        }
}

DI void fox_prompt_item(const Params& p, int l, int b, int h, int qb, char* shm) {
    bf16_t* Ks = (bf16_t*)shm; bf16_t* Vt = (bf16_t*)(shm + 17408); float* cs = (float*)(shm + 143360); float* wt = (float*)(shm + 151680);
    const int tid = tid_opaque(), wid = tid >> 6, lane = tid & 63, r = lane & 31, hh = lane >> 5;
    const int nkeys = (qb + 1) * 256;
    const float* lf = p.EX + ((size_t)b * 2048) * 32 + 16 + h; const float fb = p.b_fox_f[l * 8 + h];
    block_cumsum(nkeys, [&](int i) { return logsig(lf[(size_t)i * 32] + fb); }, cs, wt);
    const int qpos = qb * 256 + wid * 32 + r; const size_t qrow = (size_t)b * 2048 + qpos;
    bf16x8 qf[8];
    { const bf16_t* zq = p.Z + qrow * NZ + 3072 + h * 128;
#pragma unroll
      for (int ks = 0; ks < 8; ++ks) qf[ks] = *(const bf16x8*)(zq + 16 * ks + 8 * hh); }
    const float cql = cs[qpos];
    f32x16 o[4];
#pragma unroll
    for (int dt = 0; dt < 4; ++dt)
#pragma unroll
        for (int i = 0; i < 16; ++i) o[dt][i] = 0.f;
    float m = -1e30f, lsum = 0.f;
    const int nt = (qb + 1) * 4;
    const bf16_t* zk = p.Z + (size_t)b * 2048 * NZ + 4096 + h * 128; const bf16_t* zv = zk + 1024;
    int krow_[2], kc8[2], vrow[2], vc8[2];
#pragma unroll
    for (int i = 0; i < 2; ++i) { const int q = tid + 512 * i; krow_[i] = q >> 4; kc8[i] = (q & 15) * 8; const int wv = q >> 6, ln = q & 63; vrow[i] = (wv & 3) * 16 + (ln & 15); vc8[i] = ((wv >> 2) * 4 + (ln >> 4)) * 8; }
    u32x4 kreg[2], vreg[2];
#pragma unroll
    for (int i = 0; i < 2; ++i) { kreg[i] = *(const u32x4*)(zk + (size_t)krow_[i] * NZ + kc8[i]); vreg[i] = *(const u32x4*)(zv + (size_t)vrow[i] * NZ + vc8[i]); }
    const int qmaxw = qb * 256 + wid * 32 + 31;
    for (int kt = 0; kt < nt; ++kt) {
        __syncthreads();
#pragma unroll
        for (int i = 0; i < 2; ++i) {
            *(u32x4*)(Ks + krow_[i] * 136 + kc8[i]) = kreg[i];
#pragma unroll
            for (int e = 0; e < 4; ++e) { const unsigned w = vreg[i][e]; Vt[(vc8[i] + 2 * e) * 68 + vrow[i]] = (bf16_t)(w & 0xffffu); Vt[(vc8[i] + 2 * e + 1) * 68 + vrow[i]] = (bf16_t)(w >> 16); }
        }
        __syncthreads();
        if (kt + 1 < nt) {
#pragma unroll
            for (int i = 0; i < 2; ++i) { kreg[i] = *(const u32x4*)(zk + (size_t)((kt + 1) * 64 + krow_[i]) * NZ + kc8[i]); vreg[i] = *(const u32x4*)(zv + (size_t)((kt + 1) * 64 + vrow[i]) * NZ + vc8[i]); }
        }
        if (kt * 64 <= qmaxw) fox_tile<2>(Ks, 136, Vt, 68, cs + kt * 64, kt * 64, qpos, cql, qf, o, m, lsum, r, hh);
    }
    const float lt = lsum + __shfl_xor(lsum, 32); const float inv = 1.0f / lt;
    bf16_t* mo = p.MRG + qrow * DM + 1024 + h * 128;
#pragma unroll
    for (int dt = 0; dt < 4; ++dt)
#pragma unroll
        for (int g = 0; g < 4; ++g) {
            u32x2 pk; pk[0] = pk2(o[dt][4 * g] * inv, o[dt][4 * g + 1] * inv); pk[1] = pk2(o[dt][4 * g + 2] * inv, o[dt][4 * g + 3] * inv);
            *(u32x2*)(mo + dt * 32 + 8 * g + 4 * hh) = pk;
        }
}

DI void fox_sample_item(const Params& p, int l, int b, int h, char* shm) {
    float* cs = (float*)(shm + 143360); float* wt = (float*)(shm + 151680);
    const int tid = tid_opaque(), wid = tid >> 6, lane = tid & 63, r = lane & 31, hh = lane >> 5;
    const float* lfc = p.cache_logf + ((size_t)(l * 8 + b) * 2048) * 8 + h;
    const float* lfn = p.EX + ((size_t)NP + b * 32) * 32 + 16 + h; const float fb = p.b_fox_f[l * 8 + h];
    block_cumsum(2080, [&](int i) { return i < 2048 ? lfc[(size_t)i * 8] : logsig(lfn[(size_t)(i - 2048) * 32] + fb); }, cs, wt);
    const int qpos = 2048 + r; const size_t qrow = (size_t)NP + b * 32 + r;
    bf16x8 qf[8];
    { const bf16_t* zq = p.Z + qrow * NZ + 3072 + h * 128;
#pragma unroll
      for (int ks = 0; ks < 8; ++ks) qf[ks] = *(const bf16x8*)(zq + 16 * ks + 8 * hh); }
    const float cql = cs[qpos];
    f32x16 o[4];
#pragma unroll
    for (int dt = 0; dt < 4; ++dt)
#pragma unroll
        for (int i = 0; i < 16; ++i) o[dt][i] = 0.f;
    float m = -1e30f, lsum = 0.f;
    bf16_t* Ks = (bf16_t*)(shm + wid * 17920); bf16_t* Vt = (bf16_t*)(shm + wid * 17920 + 8704);
    for (int j = wid; j < 65; j += 8) {
        const float* srcK = j < 64 ? p.cache_k + (((size_t)(l * 8 + b) * 2048 + (size_t)j * 32) * 8 + h) * 128 : p.out + O_KS + (((size_t)(l * 8 + b) * 32) * 8 + h) * 128;
        const float* srcV = j < 64 ? p.cache_v + (((size_t)(l * 8 + b) * 2048 + (size_t)j * 32) * 8 + h) * 128 : p.out + O_VS + (((size_t)(l * 8 + b) * 32) * 8 + h) * 128;
#pragma unroll 8
        for (int i = 0; i < 16; ++i) {
            const int pi = i * 64 + lane, row = pi >> 5, c4 = (pi & 31) * 4;
            const f32x4 f = *(const f32x4*)(srcK + (size_t)row * 1024 + c4);
            u32x2 pk; pk[0] = pk2(f[0], f[1]); pk[1] = pk2(f[2], f[3]);
            *(u32x2*)(Ks + row * 136 + c4) = pk;
        }
#pragma unroll 8
        for (int i = 0; i < 16; ++i) {
            const int pi = i * 64 + lane, row = pi >> 5, c4 = (pi & 31) * 4;
            const f32x4 f = *(const f32x4*)(srcV + (size_t)row * 1024 + c4);
#pragma unroll
            for (int e = 0; e < 4; ++e) Vt[(c4 + e) * 36 + row] = f2bf(f[e]);
        }
        fox_tile<1>(Ks, 136, Vt, 36, cs + j * 32, j * 32, qpos, cql, qf, o, m, lsum, r, hh);
    }
    const float lt = lsum + __shfl_xor(lsum, 32);
    __syncthreads();
    float* ml = wt;
    if (hh == 0) { ml[(wid * 32 + r) * 2] = m; ml[(wid * 32 + r) * 2 + 1] = lt; }
    __syncthreads();
    float M = -1e30f;
#pragma unroll
    for (int w = 0; w < 8; ++w) M = fmaxf(M, ml[(w * 32 + r) * 2]);
    float L = 0.f;
#pragma unroll
    for (int w = 0; w < 8; ++w) L += __builtin_amdgcn_exp2f(ml[(w * 32 + r) * 2] - M) * ml[(w * 32 + r) * 2 + 1];
    const float f = __builtin_amdgcn_exp2f(m - M) / L;
    float* ow = (float*)shm + wid * (32 * 132);
#pragma unroll
    for (int dt = 0; dt < 4; ++dt)
#pragma unroll
        for (int g = 0; g < 4; ++g) {
            f32x4 v; v[0] = o[dt][4 * g] * f; v[1] = o[dt][4 * g + 1] * f; v[2] = o[dt][4 * g + 2] * f; v[3] = o[dt][4 * g + 3] * f;
            *(f32x4*)(ow + r * 132 + dt * 32 + 8 * g + 4 * hh) = v;
        }
    __syncthreads();
    {
        const int q = tid >> 4, d8 = (tid & 15) * 8; float acc[8];
#pragma unroll
        for (int e = 0; e < 8; ++e) acc[e] = 0.f;
#pragma unroll
        for (int w = 0; w < 8; ++w) {
            const float* src = (const float*)shm + w * (32 * 132) + q * 132 + d8;
            const f32x4 a = *(const f32x4*)src, c = *(const f32x4*)(src + 4);
#pragma unroll
            for (int e = 0; e < 4; ++e) { acc[e] += a[e]; acc[4 + e] += c[e]; }
        }
        u32x4 pk; pk[0] = pk2(acc[0], acc[1]); pk[1] = pk2(acc[2], acc[3]); pk[2] = pk2(acc[4], acc[5]); pk[3] = pk2(acc[6], acc[7]);
        *(u32x4*)(p.MRG + ((size_t)NP + b * 32 + q) * DM + 1024 + h * 128 + d8) = pk;
    }
}

DI void gla_item(const Params& p, int l, int grp, int b, int h, int vs, char* shm) {
    bf16_t* Qi = (bf16_t*)shm; bf16_t* Ki = (bf16_t*)(shm + 17408); bf16_t* Ket = (bf16_t*)(shm + 34816); bf16_t* Vt = (bf16_t*)(shm + 53248);
    bf16_t* At = (bf16_t*)(shm + 62464); bf16_t* St = (bf16_t*)(shm + 71680); float* dec = (float*)(shm + 89088); float* tot = (float*)(shm + 89600);
    const int tid = tid_opaque(), wid = tid >> 6, lane = tid & 63, r = lane & 31, hh = lane >> 5;
    const int nchunks = grp == 0 ? 32 : 1, nvalid = grp == 0 ? 64 : 32;
    const size_t row0 = grp == 0 ? (size_t)b * 2048 : (size_t)NP + b * 32;
    const int vi = wid >> 2, di = wid & 3;
    f32x16 S;
    float* sout = grp == 0 ? p.out + O_STP + ((size_t)((l * 4 + b) * 4 + h) * 128) * 256 : p.out + O_STS + ((size_t)((l * 8 + b) * 4 + h) * 128) * 256;
    const size_t soff = (size_t)(di * 32 + r) * 256 + vs * 64 + vi * 32 + 4 * hh;
    if (grp == 0) {
#pragma unroll
        for (int i = 0; i < 16; ++i) S[i] = 0.f;
    } else {
        const float* sin = p.state_gla + ((size_t)((l * 8 + b) * 4 + h) * 128) * 256 + soff;
#pragma unroll
        for (int g = 0; g < 4; ++g) { const f32x4 v = *(const f32x4*)(sin + 8 * g); S[4 * g] = v[0]; S[4 * g + 1] = v[1]; S[4 * g + 2] = v[2]; S[4 * g + 3] = v[3]; }
    }
#pragma unroll
    for (int i = 0; i < 16; ++i) St[(vi * 32 + crow(i, hh)) * 136 + di * 32 + r] = f2bf(S[i]);
    const int d = tid & 127, sg = tid >> 7;
    float w2[16];
#pragma unroll
    for (int k = 0; k < 16; ++k) w2[k] = p.w_gate_up[((size_t)l * 16 + k) * 512 + h * 128 + d];
    const float bias = p.b_gate[(size_t)l * 512 + h * 128 + d];
    for (int n = 0; n < nchunks; ++n) {
        const size_t rowc = row0 + (size_t)n * 64;
        float gv[16]; float cum = 0.f;
#pragma unroll
        for (int i = 0; i < 16; ++i) {
            const int s = sg * 16 + i; float gl = 0.f;
            if (s < nvalid) {
                const float* e = p.EX + (rowc + s) * 32; float x = bias;
#pragma unroll
                for (int k4 = 0; k4 < 4; ++k4) { const f32x4 ev = *(const f32x4*)(e + 4 * k4); x += ev[0] * w2[4 * k4] + ev[1] * w2[4 * k4 + 1] + ev[2] * w2[4 * k4 + 2] + ev[3] * w2[4 * k4 + 3]; }
                gl = logsig(x) * 0.0625f;
            }
            cum += gl; gv[i] = cum;
        }
        tot[sg * 128 + d] = cum;
        {
            const int s = (tid & 15) + 16 * (tid >> 7), pc = (tid >> 4) & 7;
            u32x4 vv; vv[0] = vv[1] = vv[2] = vv[3] = 0u;
            if (s < nvalid) vv = *(const u32x4*)(p.Z + (rowc + s) * NZ + 1024 + h * 256 + vs * 64 + pc * 8);
#pragma unroll
            for (int e = 0; e < 4; ++e) { Vt[(pc * 8 + 2 * e) * 72 + s] = (bf16_t)(vv[e] & 0xffffu); Vt[(pc * 8 + 2 * e + 1) * 72 + s] = (bf16_t)(vv[e] >> 16); }
        }
        __syncthreads();
        float off = 0.f;
        for (int g = 0; g < sg; ++g) off += tot[g * 128 + d];
        const float blast = tot[d] + tot[128 + d] + tot[256 + d] + tot[384 + d];
        {
            float kev[16];
#pragma unroll
            for (int i = 0; i < 16; ++i) {
                const int s = sg * 16 + i; const float bb = off + gv[i]; float q = 0.f, k = 0.f;
                if (s < nvalid) { const bf16_t* zr = p.Z + (rowc + s) * NZ + h * 128 + d; q = bf2f(zr[0]); k = bf2f(zr[512]); }
                Qi[s * 136 + d] = f2bf(q * __expf(bb)); Ki[s * 136 + d] = f2bf(k * __expf(-bb)); kev[i] = k * __expf(blast - bb);
            }
            u32x4 p0, p1;
            p0[0] = pk2(kev[0], kev[1]); p0[1] = pk2(kev[2], kev[3]); p0[2] = pk2(kev[4], kev[5]); p0[3] = pk2(kev[6], kev[7]);
            p1[0] = pk2(kev[8], kev[9]); p1[1] = pk2(kev[10], kev[11]); p1[2] = pk2(kev[12], kev[13]); p1[3] = pk2(kev[14], kev[15]);
            *(u32x4*)(Ket + d * 72 + sg * 16) = p0; *(u32x4*)(Ket + d * 72 + sg * 16 + 8) = p1;
            if (sg == 0) dec[d] = __expf(blast);
        }
        __syncthreads();
        if (wid < 3) {
            const int si = wid == 2 ? 1 : 0, ci = wid >= 1 ? 1 : 0;
            f32x16 x;
#pragma unroll
            for (int i = 0; i < 16; ++i) x[i] = 0.f;
#pragma unroll
            for (int ks = 0; ks < 8; ++ks) {
                const bf16x8 a = *(const bf16x8*)(Ki + (si * 32 + r) * 136 + 16 * ks + 8 * hh);
                const bf16x8 bq = *(const bf16x8*)(Qi + (ci * 32 + r) * 136 + 16 * ks + 8 * hh);
                x = MFMA32(a, bq, x);
            }
            const int c = ci * 32 + r;
#pragma unroll
            for (int g = 0; g < 4; ++g) {
                float v[4];
#pragma unroll
                for (int e = 0; e < 4; ++e) { const int s = si * 32 + 8 * g + 4 * hh + e; v[e] = s <= c ? x[4 * g + e] : 0.f; }
                u32x2 pk; pk[0] = pk2(v[0], v[1]); pk[1] = pk2(v[2], v[3]);
                *(u32x2*)(At + c * 72 + si * 32 + 8 * g + 4 * hh) = pk;
            }
        }
        __syncthreads();
        if (wid < 4) {
            const int v2 = wid >> 1, ci = wid & 1;
            f32x16 oa;
#pragma unroll
            for (int i = 0; i < 16; ++i) oa[i] = 0.f;
            const int nks = ci ? 4 : 2;
            for (int ks = 0; ks < nks; ++ks) {
                const bf16x8 a = *(const bf16x8*)(Vt + (v2 * 32 + r) * 72 + 16 * ks + 8 * hh);
                const bf16x8 bq = *(const bf16x8*)(At + (ci * 32 + r) * 72 + 16 * ks + 8 * hh);
                oa = MFMA32(a, bq, oa);
            }
#pragma unroll
            for (int ks = 0; ks < 8; ++ks) {
                const bf16x8 a = *(const bf16x8*)(St + (v2 * 32 + r) * 136 + 16 * ks + 8 * hh);
                const bf16x8 bq = *(const bf16x8*)(Qi + (ci * 32 + r) * 136 + 16 * ks + 8 * hh);
                oa = MFMA32(a, bq, oa);
            }
            const int c = ci * 32 + r;
            if (c < nvalid) {
                float ss = 0.f;
                float* og = p.OG + (rowc + c) * 1024 + h * 256 + vs * 64 + v2 * 32 + 4 * hh;
#pragma unroll
                for (int g = 0; g < 4; ++g) {
                    f32x4 v; v[0] = oa[4 * g]; v[1] = oa[4 * g + 1]; v[2] = oa[4 * g + 2]; v[3] = oa[4 * g + 3];
                    ss += v[0] * v[0] + v[1] * v[1] + v[2] * v[2] + v[3] * v[3];
                    *(f32x4*)(og + 8 * g) = v;
                }
                p.SSQ[((rowc + c) * 4 + h) * 16 + vs * 4 + v2 * 2 + hh] = ss;
            }
        }
        {
            const float dcy = dec[di * 32 + r];
#pragma unroll
            for (int i = 0; i < 16; ++i) S[i] *= dcy;
#pragma unroll
            for (int ks = 0; ks < 4; ++ks) {
                const bf16x8 a = *(const bf16x8*)(Vt + (vi * 32 + r) * 72 + 16 * ks + 8 * hh);
                const bf16x8 bq = *(const bf16x8*)(Ket + (di * 32 + r) * 72 + 16 * ks + 8 * hh);
                S = MFMA32(a, bq, S);
            }
        }
        __syncthreads();
#pragma unroll
        for (int i = 0; i < 16; ++i) St[(vi * 32 + crow(i, hh)) * 136 + di * 32 + r] = f2bf(S[i]);
    }
#pragma unroll
    for (int g = 0; g < 4; ++g) { f32x4 v; v[0] = S[4 * g]; v[1] = S[4 * g + 1]; v[2] = S[4 * g + 2]; v[3] = S[4 * g + 3]; *(f32x4*)(sout + soff + 8 * g) = v; }
}

DI int pop_item(unsigned* ctr, char* shm) {
    volatile int* sitem = (volatile int*)(shm + LDS_ITEM_OFF);
    __syncthreads();
    if (tid_opaque() == 0) *sitem = (int)atomicAdd(ctr, 1u);
    __syncthreads();
    return *sitem;
}
DI void mixer_phase(const Params& p, int l, char* shm) {
    for (;;) {
        const int item = pop_item(p.ctr + l * 4 + 0, shm);
        if (item >= 192) break;
        if (item < 64) gla_item(p, l, 0, item >> 4, (item >> 2) & 3, item & 3, shm);
        else { const int j = item - 64; gla_item(p, l, 1, j >> 4, (j >> 2) & 3, j & 3, shm); }
    }
    for (;;) {
        const int j = pop_item(p.ctr + l * 4 + 1, shm);
        if (j >= 256) break;
        fox_prompt_item(p, l, (j & 31) >> 3, j & 7, 7 - (j >> 5), shm);
    }
    for (;;) {
        const int j = pop_item(p.ctr + l * 4 + 2, shm);
        if (j >= 64) break;
        fox_sample_item(p, l, j >> 3, j & 7, shm);
    }
}

DI void gla_finalize(const Params& p, int l) {
    for (int idx = blockIdx.x * 512 + tid_opaque(); idx < MT * 8; idx += gridDim.x * 512) {
        const int row = idx >> 3, hd = idx & 7; const float lf = logsig(p.EX[(size_t)row * 32 + 16 + hd] + p.b_fox_f[l * 8 + hd]);
        if (row < NP) p.out[O_LFP + ((size_t)l * NP + row) * 8 + hd] = lf; else p.out[O_LFS + ((size_t)l * NS + row - NP) * 8 + hd] = lf;
    }
    const size_t total = (size_t)MT * 128;
    for (size_t idx = (size_t)blockIdx.x * 512 + tid_opaque(); idx < total; idx += (size_t)gridDim.x * 512) {
        const size_t row = idx >> 7; const int c8 = (int)(idx & 127) * 8, h = c8 >> 8;
        const float* sq = p.SSQ + (row * 4 + h) * 16; float ss = 0.f;
#pragma unroll
        for (int k = 0; k < 4; ++k) { const f32x4 v = *(const f32x4*)(sq + 4 * k); ss += v[0]; ss += v[1]; ss += v[2]; ss += v[3]; }
        const float rs = rsqrtf(ss * (1.0f / 256.0f) + EPS);
        const f32x4 o0 = *(const f32x4*)(p.OG + row * 1024 + c8), o1 = *(const f32x4*)(p.OG + row * 1024 + c8 + 4);
        const f32x4 g0 = *(const f32x4*)(p.g_onorm + (size_t)l * 1024 + c8), g1 = *(const f32x4*)(p.g_onorm + (size_t)l * 1024 + c8 + 4);
        const u32x4 rg = *(const u32x4*)(p.Z + row * NZ + 2048 + c8);
        float v[8];
#pragma unroll
        for (int e = 0; e < 4; ++e) {
            const float ra = bflo(rg[e]), rb = bfhi(rg[e]);
            const float oa = (2 * e < 4 ? o0[(2 * e) & 3] : o1[(2 * e) & 3]), ob = (2 * e + 1 < 4 ? o0[(2 * e + 1) & 3] : o1[(2 * e + 1) & 3]);
            const float ga = (2 * e < 4 ? g0[(2 * e) & 3] : g1[(2 * e) & 3]), gb = (2 * e + 1 < 4 ? g0[(2 * e + 1) & 3] : g1[(2 * e + 1) & 3]);
            v[2 * e] = oa * rs * ga * (ra / (1.0f + __expf(-ra))); v[2 * e + 1] = ob * rs * gb * (rb / (1.0f + __expf(-rb)));
        }
        u32x4 pk; pk[0] = pk2(v[0], v[1]); pk[1] = pk2(v[2], v[3]); pk[2] = pk2(v[4], v[5]); pk[3] = pk2(v[6], v[7]);
        *(u32x4*)(p.MRG + row * DM + c8) = pk;
    }
}

constexpr int NPHASE = 17;
template <int S>
DI void run_stage(const Params& p, int l, char* shm) {
    float* yp = p.out + O_YP; float* ys = p.out + O_YS;
    if constexpr (S == 8) { phase0(p, shm); }
    if constexpr (S == 0) { EpiIn E; E.Z = p.Z; E.EX = p.EX; E.outk_p = p.out + O_KP + (size_t)l * NP * 1024; E.outv_p = p.out + O_VP + (size_t)l * NP * 1024;
              E.outk_s = p.out + O_KS + (size_t)l * NS * 1024; E.outv_s = p.out + O_VS + (size_t)l * NS * 1024;
              run_gemm(shm, p.H, p.WinT + (size_t)l * NIN * DM, MT, NIN, DM, E); }
    if constexpr (S == 1) mixer_phase(p, l, shm);
    if constexpr (S == 2) gla_finalize(p, l);
    if constexpr (S == 3) { EpiRaw E; E.C = p.RAW; run_gemm(shm, p.MRG, p.WoutT + (size_t)l * DM * DM, MT, DM, DM, E); }
    if constexpr (S == 4) norm_rows(l == 0 ? p.x_prompt : yp, l == 0 ? p.x_sample : ys, p.RAW, p.g_mix_post + (size_t)l * DM, p.g_mlp_pre + (size_t)l * DM, yp, ys, p.H);
    if constexpr (S == 5) { EpiUp E; E.U = p.U; run_gemm(shm, p.H, p.WupT + (size_t)l * DFF * DM, MT, DFF, DM, E); }
    if constexpr (S == 6) { EpiRaw E; E.C = p.RAW; run_gemm(shm, p.U, p.WdownT + (size_t)l * DM * DFF, MT, DM, DFF, E); }
    if constexpr (S == 7) norm_rows(yp, ys, p.RAW, p.g_mlp_post + (size_t)l * DM, l + 1 < 2 ? p.g_mix_pre + (size_t)(l + 1) * DM : nullptr, yp, ys, p.H);
}

#if MEGA
DI Params load_params() {
    Params r{};
#if defined(__HIP_DEVICE_COMPILE__)
    const __attribute__((address_space(4))) unsigned long long* kp = (const __attribute__((address_space(4))) unsigned long long*)__builtin_amdgcn_kernarg_segment_ptr();
    asm volatile("" : "+s"(kp));
    unsigned long long* d = (unsigned long long*)&r;
#pragma unroll
    for (int i = 0; i < (int)(sizeof(Params) / 8); ++i) d[i] = kp[i];
#endif
    return r;
}
__global__ void __launch_bounds__(512, 2) k_mega(Params p_unused) {
    extern __shared__ __attribute__((aligned(16))) char shm[];
    cg::grid_group grid = cg::this_grid();
#define STAGE(S, l) { const Params q = load_params(); run_stage<S>(q, l, shm); }
    STAGE(8, 0)
#define LAYER(l) grid.sync(); STAGE(0, l) grid.sync(); STAGE(1, l) grid.sync(); STAGE(2, l) grid.sync(); STAGE(3, l) \
    grid.sync(); STAGE(4, l) grid.sync(); STAGE(5, l) grid.sync(); STAGE(6, l) grid.sync(); STAGE(7, l)
    LAYER(0)
    LAYER(1)
#undef LAYER
#undef STAGE
}
#else
template <int S>
__global__ void __launch_bounds__(512, 2) k_one(Params p, int l) {
    extern __shared__ __attribute__((aligned(16))) char shm[];
    run_stage<S>(p, l, shm);
}
template <int S> static void launch_one(const Params& p, int l, hipStream_t stream) {
    (void)hipFuncSetAttribute((const void*)k_one<S>, hipFuncAttributeMaxDynamicSharedMemorySize, LDS_BYTES);
    hipLaunchKernelGGL(k_one<S>, dim3(256), dim3(512), LDS_BYTES, stream, p, l);
}
#endif

extern "C" void kernel_launch(void* const* d_in, const int* in_sizes, int n_in, void* d_out, int out_size, void* d_ws, size_t ws_size, hipStream_t stream) {
    Params p{};
    const float* const* in = (const float* const*)d_in;
    p.x_prompt = in[0]; p.x_sample = in[1]; p.cache_k = in[2]; p.cache_v = in[3]; p.cache_logf = in[4]; p.state_gla = in[5]; p.g_mix_pre = in[6]; p.w_in = in[7];
    p.w_gate_up = in[8]; p.b_gate = in[9]; p.b_fox_f = in[10]; p.g_onorm = in[11]; p.w_out = in[12]; p.g_mix_post = in[13]; p.g_mlp_pre = in[14]; p.w_up = in[15];
    p.w_down = in[16]; p.g_mlp_post = in[17];
    p.out = (float*)d_out;
    char* w = (char*)d_ws; size_t off = 0;
    auto take = [&](size_t bytes) { char* r = w + off; off += (bytes + 255) & ~(size_t)255; return r; };
    p.ctr = (unsigned*)take(256);
    p.WinT = (bf16_t*)take((size_t)2 * NIN * DM * 2); p.WoutT = (bf16_t*)take((size_t)2 * DM * DM * 2);
    p.WupT = (bf16_t*)take((size_t)2 * DFF * DM * 2); p.WdownT = (bf16_t*)take((size_t)2 * DM * DFF * 2);
    p.H = (bf16_t*)take((size_t)MT * DM * 2); p.MRG = (bf16_t*)take((size_t)MT * DM * 2); p.Z = (bf16_t*)take((size_t)MT * NZ * 2);
    p.U = (bf16_t*)take((size_t)MT * DFF * 2);
    p.EX = (float*)take((size_t)MT * 32 * 4); p.RAW = (float*)take((size_t)MT * DM * 4); p.OG = (float*)take((size_t)MT * 1024 * 4); p.SSQ = (float*)take((size_t)MT * 64 * 4);
    if (off > ws_size) { fprintf(stderr, "workspace too small: need %zu have %zu\n", off, ws_size); return; }
#if MEGA
    static int grid_blocks = 0;
    if (!grid_blocks) {
        (void)hipFuncSetAttribute((const void*)k_mega, hipFuncAttributeMaxDynamicSharedMemorySize, LDS_BYTES);
        int dev = 0, cus = 0, per_cu = 0; hipGetDevice(&dev); hipDeviceGetAttribute(&cus, hipDeviceAttributeMultiprocessorCount, dev);
        hipOccupancyMaxActiveBlocksPerMultiprocessor(&per_cu, k_mega, 512, LDS_BYTES);
        if (per_cu < 1) per_cu = 1;
        grid_blocks = cus;
    }
    void* args[] = {&p};
    hipError_t e = hipLaunchCooperativeKernel((void*)k_mega, dim3(grid_blocks), dim3(512), args, LDS_BYTES, stream);
    if (e != hipSuccess) fprintf(stderr, "cooperative launch failed: %s (grid %d)\n", hipGetErrorString(e), grid_blocks);
#else
    launch_one<8>(p, 0, stream);
    for (int l = 0; l < 2; ++l) { launch_one<0>(p, l, stream); launch_one<1>(p, l, stream); launch_one<2>(p, l, stream); launch_one<3>(p, l, stream);
        launch_one<4>(p, l, stream); launch_one<5>(p, l, stream); launch_one<6>(p, l, stream); launch_one<7>(p, l, stream); }
#endif
}
```

```cpp
#include <hip/hip_runtime.h>
#include <hip/hip_cooperative_groups.h>
#include <cstdio>
namespace cg = cooperative_groups;
#ifndef MEGA
#define MEGA 1
#endif
#ifndef PROBE
#define PROBE 0
#endif
__device__ __forceinline__ int tid_opaque() { int t = threadIdx.x; asm volatile("" : "+v"(t)); return t; }
#define XB_TMO      128
#define XB_XCNT(j)  (256  + 64 * (j))
#define XB_XSUB(j)  (1280 + 64 * (j))
#define XB_XGEN(j)  (2304 + 64 * (j))
#define XB_TOP      3328
#define XB_TOPGEN   3392
#define XCD_BAR_WORDS 3456
#define XB_SPIN_CAP (1u << 18)
#define LAS __attribute__((address_space(3)))

__device__ __forceinline__ unsigned xb_ld(unsigned* p)              { return __hip_atomic_load(p, __ATOMIC_RELAXED, __HIP_MEMORY_SCOPE_AGENT); }
__device__ __forceinline__ unsigned xb_add(unsigned* p, unsigned v) { return __hip_atomic_fetch_add(p, v, __ATOMIC_RELAXED, __HIP_MEMORY_SCOPE_AGENT); }
__device__ __forceinline__ unsigned xb_xcc_id() { return (unsigned)__builtin_amdgcn_s_getreg((3 << 11) | 20) & 0xFu; }
#define XB_SPIN(cond, bar) do { unsigned _sp = 0; while (cond) { __builtin_amdgcn_s_sleep(1); \
    if ((++_sp & 255u) == 0u) { if (xb_ld(&(bar)[XB_TMO])) break; if (_sp > XB_SPIN_CAP) { atomicAdd(&(bar)[XB_TMO], 1u); break; } } } } while (0)

struct XcdBarrier {
    unsigned* bar; unsigned x;
    volatile LAS unsigned* st;
};

__device__ __forceinline__ XcdBarrier xcd_barrier_post(unsigned* bar, volatile LAS unsigned* st) {
    XcdBarrier b; b.bar = bar; b.x = xb_xcc_id(); b.st = st;
    if (threadIdx.x == 0) (void)xb_add(&bar[XB_XCNT(b.x)], 1u);
    return b;
}
__device__ __forceinline__ void xcd_barrier_complete(unsigned* bar, unsigned x, unsigned& nloc, unsigned& nx) {
    const unsigned G = gridDim.x * gridDim.y * gridDim.z;
    unsigned sum, cnt, mine, sp = 0u;
    for (;;) {
        sum = 0u; cnt = 0u; mine = 0u;
#pragma unroll
        for (unsigned j = 0; j < 16; ++j) { const unsigned c = xb_ld(&bar[XB_XCNT(j)]); sum += c; cnt += (c > 0u) ? 1u : 0u; mine = (j == x) ? c : mine; }
        if (sum == G) break;
        __builtin_amdgcn_s_sleep(1);
        if ((++sp & 255u) == 0u) { if (xb_ld(&bar[XB_TMO])) break; if (sp > XB_SPIN_CAP) { atomicAdd(&bar[XB_TMO], 1u); break; } }
    }
    nloc = mine > 0u ? mine : 1u; nx = cnt > 0u ? cnt : 1u;
}

__device__ __forceinline__ void xcd_barrier(const XcdBarrier& b) {
    asm volatile("s_waitcnt vmcnt(0)" ::: "memory");
    __syncthreads();
    if (threadIdx.x == 0) {
        unsigned* bar = b.bar;
        __builtin_amdgcn_s_waitcnt(0);
        unsigned nloc = b.st[0], nx = b.st[1];
        if (nloc == 0u) { xcd_barrier_complete(bar, b.x, nloc, nx); b.st[0] = nloc; b.st[1] = nx; }
        const unsigned old = xb_add(&bar[XB_XSUB(b.x)], 1u);
        const unsigned gen = old / nloc;
        if (old + 1u == (gen + 1u) * nloc) {
            __builtin_amdgcn_fence(__ATOMIC_RELEASE, "agent");
            asm volatile("s_waitcnt vmcnt(0)" ::: "memory");
            const unsigned og = xb_add(&bar[XB_TOP], 1u);
            const unsigned tg = og / nx;
            if (og + 1u == (tg + 1u) * nx) xb_add(&bar[XB_TOPGEN], 1u);
            else XB_SPIN(xb_ld(&bar[XB_TOPGEN]) == tg, bar);
            __builtin_amdgcn_fence(__ATOMIC_ACQUIRE, "agent");
            xb_add(&bar[XB_XGEN(b.x)], 1u);
            asm volatile("s_waitcnt vmcnt(0)" ::: "memory");
        } else {
            XB_SPIN(xb_ld(&bar[XB_XGEN(b.x)]) == gen, bar);
            __builtin_amdgcn_fence(__ATOMIC_ACQUIRE, "agent");
            asm volatile("s_waitcnt vmcnt(0)" ::: "memory");
        }
    }
    __syncthreads();
}
namespace pg8 {
#define PG8_LAS __attribute__((address_space(3)))
typedef unsigned short bf16_t;
typedef short bf16x8 __attribute__((ext_vector_type(8)));
typedef float f32x4 __attribute__((ext_vector_type(4)));
typedef unsigned u32x4 __attribute__((ext_vector_type(4)));
constexpr int BM = 256, BK = 64, HALF = 128, HTB = HALF * BK * 2  , STAGE_BYTES = 8 * HTB, NXCD = 8, WGM = 8;

__host__ __device__ __forceinline__ int lds_byte(int r, int c) { const int st = (r >> 4) * 2 + (c >> 5), rr = r & 15, cc = c & 31, ob = rr * 64 + cc * 2; return st * 1024 + (ob ^ (((ob >> 9) & 1) << 5)); }
__host__ __device__ __forceinline__ void stage_rc(int b, int& R, int& C) { const int st = b / 1024, sb = b % 1024, swz = sb ^ (((sb >> 9) & 1) << 5); R = (st >> 1) * 16 + swz / 64; C = (st & 1) * 32 + (swz % 64) / 2; }
__host__ __device__ __forceinline__ int perm32(int rho) { const int n = rho >> 4, i = rho & 15; return 8 * (i >> 2) + 4 * n + (i & 3); }

struct Unit { int pm, pn; };
struct Gemm { const bf16_t* A; const bf16_t* Bt; int M, N, K; int lda, ldb, nct, ksub; };

struct StaticOrder {
    int nM, nN, nwg, G, c;
    __host__ __device__ void init(int M, int N, int G_, int c_) { nM = M / BM; nN = N / BM; nwg = nM * nN; G = G_; c = c_; }
    __host__ __device__ bool next(int i, Unit& u) const {
        const long L = (long)i * G + c; if (L >= nwg) return false;
        int wgid = (int)L; { const int q = nwg / NXCD, r = nwg % NXCD, xcd = wgid % NXCD, off = wgid / NXCD; wgid = (xcd < r ? xcd * (q + 1) : r * (q + 1) + (xcd - r) * q) + off; }
        const int nig = WGM * nN, gid = wgid / nig, fm = gid * WGM, gsz = (nM - fm) < WGM ? (nM - fm) : WGM;
        u.pm = fm + ((wgid % nig) % gsz); u.pn = (wgid % nig) / gsz; return true;
    }
    __device__ __forceinline__ void a_ready(const Unit&) const {}
    __device__ __forceinline__ void done(const Unit&) const {}
};

template <class Epi, class Sched, bool STAMP = false>
__device__ __forceinline__ void gemm_phase(PG8_LAS unsigned char* lds, const Gemm g, const Sched& S, const Epi& E, unsigned long long* stamps) {
    const int tid = tid_opaque(), wid = __builtin_amdgcn_readfirstlane(tid >> 6), lane = tid & 63, wr = wid >> 2, wc = wid & 3, fr = lane & 15, fq = lane >> 4;
    const int K = g.K, nt = K / BK;
    int ts_lo = 0, ts_hi = 0, nts = 0; const unsigned long long rt_entry = STAMP ? (unsigned long long)wall_clock64() : 0ull;
#define PG8_STAMP() do { if (STAMP && wid == 0 && nts < 64) { const unsigned long long _c = (unsigned long long)clock64(); \
        ts_lo = (lane == nts) ? (int)(unsigned)_c : ts_lo; ts_hi = (lane == nts) ? (int)(unsigned)(_c >> 32) : ts_hi; ++nts; } } while (0)
    PG8_STAMP();
    unsigned voffA[2], voffB[2];
#pragma unroll
    for (int i = 0; i < 2; ++i) { int R, C; stage_rc(tid * 16 + i * 8192, R, C); const int Rb = Epi::PERM ? ((R & ~31) + perm32(R & 31)) : R;
        voffA[i] = (unsigned)(R * g.lda + C) * 2u; voffB[i] = (unsigned)(Rb * g.ldb + C) * 2u; }
    const size_t kstep = (size_t)(BK * 2);
    const size_t hstepA = (size_t)HALF * g.lda * 2, hstepB = (size_t)HALF * g.ldb * 2;
    const size_t tstepA = 2 * hstepA, tstepB = 2 * hstepB;
    const unsigned ldsw = (unsigned)wid * 1024u;
    const int aoff = lds_byte(wr * 64 + fr, fq * 8), boff = lds_byte(wc * 32 + fr, fq * 8);
#define PG8_SA(b, h) (((b) * 2 + (h)) * HTB)
#define PG8_SB(b, h) ((4 + (b) * 2 + (h)) * HTB)
#define PG8_STAGE(bufoff, gbase, voff) do { _Pragma("unroll") for (int _i = 0; _i < 2; ++_i) \
        __builtin_amdgcn_global_load_lds((const unsigned*)((const char*)(gbase) + (voff)[_i]), (PG8_LAS unsigned*)(lds + (bufoff) + ldsw + _i * 8192), 16, 0, 0); } while (0)
#define PG8_LDA(dst, b, h) do { _Pragma("unroll") for (int m = 0; m < 4; ++m) _Pragma("unroll") for (int k = 0; k < 2; ++k) dst[m][k] = *(const PG8_LAS bf16x8*)(lds + PG8_SA(b, h) + aoff + m * 2048 + k * 1024); } while (0)
#define PG8_LDB(dst, b, h) do { _Pragma("unroll") for (int n = 0; n < 2; ++n) _Pragma("unroll") for (int k = 0; k < 2; ++k) dst[n][k] = *(const PG8_LAS bf16x8*)(lds + PG8_SB(b, h) + boff + n * 2048 + k * 1024); } while (0)
#define PG8_MMA(ai, bj, At, Bt) do { __builtin_amdgcn_s_setprio(1); _Pragma("unroll") for (int m = 0; m < 4; ++m) _Pragma("unroll") for (int n = 0; n < 2; ++n) _Pragma("unroll") for (int k = 0; k < 2; ++k) \
        acc[ai][bj][m][n] = __builtin_amdgcn_mfma_f32_16x16x32_bf16(Bt[n][k], At[m][k], acc[ai][bj][m][n], 0, 0, 0); __builtin_amdgcn_s_setprio(0); } while (0)
#define PG8_WAIT_V(n) asm volatile("s_waitcnt vmcnt(" #n ")" ::: "memory")
#define PG8_WAIT_L(n) asm volatile("s_waitcnt lgkmcnt(" #n ")" ::: "memory")
#define PG8_BAR __builtin_amdgcn_s_barrier()
#define PG8_SCHED __builtin_amdgcn_sched_barrier(0)
    Unit cur, nxt; int ui = 0;
    if (!S.next(0, cur)) return;
    f32x4 acc[2][2][4][2];
#pragma unroll
    for (int a = 0; a < 2; ++a)
#pragma unroll
        for (int b = 0; b < 2; ++b)
#pragma unroll
            for (int m = 0; m < 4; ++m)
#pragma unroll
                for (int n = 0; n < 2; ++n) acc[a][b][m][n] = (f32x4){0.f, 0.f, 0.f, 0.f};
    bf16x8 At[4][2], B0[2][2], B1[2][2];
    const char* cA = (const char*)g.A + (size_t)cur.pm * tstepA + (size_t)(cur.pn / g.nct) * g.ksub * 2; const char* cB = (const char*)g.Bt + (size_t)(cur.pn % g.nct) * tstepB + (size_t)(cur.pn / g.nct) * g.ksub * 2;
    S.a_ready(cur);
    PG8_STAGE(PG8_SB(0, 0), cB, voffB); PG8_STAGE(PG8_SA(0, 0), cA, voffA); PG8_STAGE(PG8_SB(0, 1), cB + hstepB, voffB); PG8_STAGE(PG8_SA(0, 1), cA + hstepA, voffA);
    if (wr == 1) PG8_BAR;
    PG8_WAIT_V(4); PG8_BAR;
    PG8_STAGE(PG8_SB(1, 0), cB + kstep, voffB); PG8_STAGE(PG8_SA(1, 0), cA + kstep, voffA); PG8_STAGE(PG8_SB(1, 1), cB + hstepB + kstep, voffB);
    PG8_WAIT_V(6); PG8_BAR;
    PG8_STAMP();
    for (;;) {
        const bool has_next = S.next(ui + 1, nxt);
        const char* nA = has_next ? (const char*)g.A + (size_t)nxt.pm * tstepA + (size_t)(nxt.pn / g.nct) * g.ksub * 2 : cA; const char* nB = has_next ? (const char*)g.Bt + (size_t)(nxt.pn % g.nct) * tstepB + (size_t)(nxt.pn / g.nct) * g.ksub * 2 : cB;
        for (int t = 0; t < nt; t += 2) {
            const bool last = (t == nt - 2);
            const char* a1 = cA + (size_t)(t + 1) * kstep;
            const char* a2 = last ? nA : cA + (size_t)(t + 2) * kstep; const char* b2 = last ? nB : cB + (size_t)(t + 2) * kstep;
            const char* a3 = a2 + kstep; const char* b3 = b2 + kstep;
            if (last && has_next) S.a_ready(nxt);
            PG8_LDB(B0, 0, 0); PG8_SCHED; PG8_LDA(At, 0, 0); PG8_STAGE(PG8_SA(1, 1), a1 + hstepA, voffA);
            PG8_WAIT_L(8); PG8_BAR; PG8_WAIT_L(0); PG8_MMA(0, 0, At, B0); PG8_BAR; PG8_SCHED;
            PG8_LDB(B1, 0, 1); PG8_STAGE(PG8_SB(0, 0), b2, voffB);
            PG8_BAR; PG8_WAIT_L(0); PG8_MMA(0, 1, At, B1); PG8_BAR;
            PG8_LDA(At, 0, 1); PG8_STAGE(PG8_SA(0, 0), a2, voffA);
            PG8_BAR; PG8_WAIT_L(0); PG8_MMA(1, 0, At, B0); PG8_BAR; PG8_SCHED;
            PG8_STAGE(PG8_SB(0, 1), b2 + hstepB, voffB);
            PG8_WAIT_V(6); PG8_BAR; PG8_MMA(1, 1, At, B1); PG8_BAR;
            PG8_LDB(B0, 1, 0); PG8_SCHED; PG8_LDA(At, 1, 0); PG8_STAGE(PG8_SA(0, 1), a2 + hstepA, voffA);
            PG8_WAIT_L(8); PG8_BAR; PG8_WAIT_L(0); PG8_MMA(0, 0, At, B0); PG8_BAR; PG8_SCHED;
            PG8_LDB(B1, 1, 1); PG8_STAGE(PG8_SB(1, 0), b3, voffB);
            PG8_BAR; PG8_WAIT_L(0); PG8_MMA(0, 1, At, B1); PG8_BAR;
            PG8_LDA(At, 1, 1); PG8_STAGE(PG8_SA(1, 0), a3, voffA);
            PG8_BAR; PG8_WAIT_L(0); PG8_MMA(1, 0, At, B0); PG8_BAR; PG8_SCHED;
            PG8_STAGE(PG8_SB(1, 1), b3 + hstepB, voffB);
            PG8_WAIT_V(6); PG8_BAR; PG8_MMA(1, 1, At, B1); PG8_BAR;
        }
        PG8_STAMP();
        if constexpr (!Epi::AFTER_DRAIN) { E(acc, cur, wr, wc, fr, fq); S.done(cur); }
        PG8_STAMP();
        if (!has_next) break;
#pragma unroll
        for (int a = 0; a < 2; ++a)
#pragma unroll
            for (int b = 0; b < 2; ++b)
#pragma unroll
                for (int m = 0; m < 4; ++m)
#pragma unroll
                    for (int n = 0; n < 2; ++n) acc[a][b][m][n] = (f32x4){0.f, 0.f, 0.f, 0.f};
        cur = nxt; cA = nA; cB = nB; ++ui;
    }
    PG8_WAIT_V(0);
    if (wr == 0) PG8_BAR;
    PG8_BAR;
    if constexpr (Epi::AFTER_DRAIN) { E.fused(acc, cur, wr, wc, fr, fq, lds, wid, lane); S.done(cur); }
    PG8_STAMP();
    if (STAMP && wid == 0) { stamps[lane] = lane < nts ? (((unsigned long long)(unsigned)ts_hi << 32) | (unsigned)ts_lo) : 0ull;
        if (lane == 62) stamps[62] = rt_entry; if (lane == 63) stamps[63] = (unsigned long long)wall_clock64(); }
#undef PG8_STAMP
#undef PG8_SA
#undef PG8_SB
#undef PG8_STAGE
#undef PG8_LDA
#undef PG8_LDB
#undef PG8_MMA
#undef PG8_WAIT_V
#undef PG8_WAIT_L
#undef PG8_BAR
#undef PG8_SCHED
}
}

using pg8::bf16_t; using pg8::bf16x8; using pg8::f32x4; using pg8::u32x4;
typedef short s16x4 __attribute__((ext_vector_type(4)));
typedef float f32x16 __attribute__((ext_vector_type(16)));
typedef unsigned u32x2 __attribute__((ext_vector_type(2)));
#define DI __device__ __forceinline__
#define MFMA32(a, b, c) __builtin_amdgcn_mfma_f32_32x32x16_bf16((a), (b), (c), 0, 0, 0)

constexpr int NP = 8192, NS = 256, MT = 8448, DM = 2048, NZ = 6144, NIN = 6400, DFF = 8192;
constexpr float EPS = 1e-6f, LOG2E = 1.4426950408889634f;
constexpr int LDS_BYTES = 154112;
constexpr int LDS_ITEM_OFF = 153792;
constexpr size_t O_YP = 0, O_YS = 16777216, O_KP = 17301504, O_VP = 34078720, O_LFP = 50855936, O_STP = 50987008,
                 O_KS = 52035584, O_VS = 52559872, O_LFS = 53084160, O_STS = 53088256;

struct Params {
    const float *x_prompt, *x_sample, *cache_k, *cache_v, *cache_logf, *state_gla, *g_mix_pre, *w_in, *w_gate_up, *b_gate, *b_fox_f,
                *g_onorm, *w_out, *g_mix_post, *g_mlp_pre, *w_up, *w_down, *g_mlp_post;
    float* out;
    bf16_t *WinT, *WoutT, *WupT, *WdownT, *H, *MRG, *Z, *U;
    bf16_t* RAW;
    bf16_t* YB;
    float *EX, *OG, *DEC, *KVT, *PART, *FSO, *FSML;
    bf16_t *SS, *QI;
    unsigned* ctr;
    unsigned* bar;
};

DI unsigned pk2(float a, float b) { typedef __bf16 v2 __attribute__((ext_vector_type(2))); v2 v; v[0] = (__bf16)a; v[1] = (__bf16)b; return __builtin_bit_cast(unsigned, v); }
DI bf16_t f2bf(float a) { return __builtin_bit_cast(unsigned short, (__bf16)a); }
DI float bf2f(unsigned u) { return __uint_as_float(u << 16); }
DI float bflo(unsigned u) { return __uint_as_float(u << 16); }
DI float bfhi(unsigned u) { return __uint_as_float(u & 0xffff0000u); }
DI float logsig(float x) { return fminf(x, 0.f) - log1pf(__expf(-fabsf(x))); }
DI int crow(int reg, int h) { return (reg & 3) + 8 * (reg >> 2) + 4 * h; }
DI float wave_sum(float v) {
#pragma unroll
    for (int o = 32; o >= 1; o >>= 1) v += __shfl_xor(v, o);
    return v;
}

struct EpiIn {
    static constexpr bool PERM = true, AFTER_DRAIN = false;
    bf16_t* Z; float* EX; float *outk_p, *outv_p, *outk_s, *outv_s; int row_base, pn_base;
    DI void operator()(const f32x4 (&acc)[2][2][4][2], const pg8::Unit& u, int wr, int wc, int fr, int fq) const {
        const int row0 = row_base + u.pm * 256 + wr * 64 + fr, pn = pn_base + u.pn;
        const float sc = pn < 2 ? 0.08838834764831845f : 1.0f;
#pragma unroll
        for (int ai = 0; ai < 2; ++ai)
#pragma unroll
            for (int m = 0; m < 4; ++m) {
                const int row = row0 + ai * 128 + m * 16;
#pragma unroll
                for (int bj = 0; bj < 2; ++bj) {
                    const int cc = bj * 128 + wc * 32 + 8 * fq;
                    const f32x4 v0 = acc[ai][bj][m][0], v1 = acc[ai][bj][m][1];
                    if (pn < 24) {
                        u32x4 pk; pk[0] = pk2(v0[0] * sc, v0[1] * sc); pk[1] = pk2(v0[2] * sc, v0[3] * sc); pk[2] = pk2(v1[0] * sc, v1[1] * sc); pk[3] = pk2(v1[2] * sc, v1[3] * sc);
                        *(u32x4*)(Z + (size_t)row * NZ + pn * 256 + cc) = pk;
                        if (pn >= 16) {
                            const bool isk = pn < 20; const int gc = (pn - (isk ? 16 : 20)) * 256 + cc;
                            float* dst = row < NP ? (isk ? outk_p : outv_p) + (size_t)row * 1024 + gc : (isk ? outk_s : outv_s) + (size_t)(row - NP) * 1024 + gc;
                            *(f32x4*)dst = v0; *(f32x4*)(dst + 4) = v1;
                        }
                    } else if (cc < 24) {
                        float* ex = EX + (size_t)row * 32 + cc;
                        *(f32x4*)ex = v0; *(f32x4*)(ex + 4) = v1;
                    }
                }
            }
    }
};
struct EpiRaw {
    static constexpr bool PERM = true, AFTER_DRAIN = false;
    bf16_t* C;
    DI void operator()(const f32x4 (&acc)[2][2][4][2], const pg8::Unit& u, int wr, int wc, int fr, int fq) const {
        const int row0 = u.pm * 256 + wr * 64 + fr, col0 = u.pn * 256 + wc * 32 + 8 * fq;
#pragma unroll
        for (int ai = 0; ai < 2; ++ai)
#pragma unroll
            for (int m = 0; m < 4; ++m) {
                bf16_t* rp = C + (size_t)(row0 + ai * 128 + m * 16) * DM + col0;
#pragma unroll
                for (int bj = 0; bj < 2; ++bj) {
                    const f32x4 a = acc[ai][bj][m][0], b = acc[ai][bj][m][1];
                    u32x4 pk; pk[0] = pk2(a[0], a[1]); pk[1] = pk2(a[2], a[3]); pk[2] = pk2(b[0], b[1]); pk[3] = pk2(b[2], b[3]);
                    *(u32x4*)(rp + bj * 128) = pk;
                }
            }
    }
};
struct EpiUp {
    static constexpr bool PERM = true, AFTER_DRAIN = false;
    bf16_t* U;
    DI void operator()(const f32x4 (&acc)[2][2][4][2], const pg8::Unit& u, int wr, int wc, int fr, int fq) const {
        const int row0 = u.pm * 256 + wr * 64 + fr, col0 = u.pn * 256 + wc * 32 + 8 * fq;
#pragma unroll
        for (int ai = 0; ai < 2; ++ai)
#pragma unroll
            for (int m = 0; m < 4; ++m) {
                bf16_t* rp = U + (size_t)(row0 + ai * 128 + m * 16) * DFF + col0;
#pragma unroll
                for (int bj = 0; bj < 2; ++bj) {
                    f32x4 a = acc[ai][bj][m][0], b = acc[ai][bj][m][1];
#pragma unroll
                    for (int e = 0; e < 4; ++e) { a[e] = fmaxf(a[e], 0.f); a[e] *= a[e]; b[e] = fmaxf(b[e], 0.f); b[e] *= b[e]; }
                    u32x4 pk; pk[0] = pk2(a[0], a[1]); pk[1] = pk2(a[2], a[3]); pk[2] = pk2(b[0], b[1]); pk[3] = pk2(b[2], b[3]);
                    *(u32x4*)(rp + bj * 128) = pk;
                }
            }
    }
};

struct EpiPart {
    static constexpr bool PERM = true, AFTER_DRAIN = false;
    bf16_t* P;
    DI void operator()(const f32x4 (&acc)[2][2][4][2], const pg8::Unit& u, int wr, int wc, int fr, int fq) const {
        const int split = u.pn >> 3, ct = u.pn & 7;
        const int row0 = wr * 64 + fr, col0 = ct * 256 + wc * 32 + 8 * fq;
#pragma unroll
        for (int ai = 0; ai < 2; ++ai)
#pragma unroll
            for (int m = 0; m < 4; ++m) {
                bf16_t* rp = P + ((size_t)split * 256 + row0 + ai * 128 + m * 16) * DM + col0;
#pragma unroll
                for (int bj = 0; bj < 2; ++bj) { const f32x4 a = acc[ai][bj][m][0], b = acc[ai][bj][m][1];
                    u32x4 pk; pk[0] = pk2(a[0], a[1]); pk[1] = pk2(a[2], a[3]); pk[2] = pk2(b[0], b[1]); pk[3] = pk2(b[2], b[3]); *(u32x4*)(rp + bj * 128) = pk; }
            }
    }
};

template <class Epi>
DI void run_gemm(char* shm, const bf16_t* A, const bf16_t* Bt, int M, int N, int K, int lda, int ldb, int nsplit, const Epi& E, int G = 0, int c = 0) {
    pg8::Gemm g; g.A = A; g.Bt = Bt; g.M = M; g.N = N * nsplit; g.K = K; g.lda = lda; g.ldb = ldb; g.nct = N / 256; g.ksub = K;
    if (G == 0) { G = (int)gridDim.x; c = (int)blockIdx.x; }
    pg8::StaticOrder S; S.init(M, N * nsplit, G, c);
    pg8::gemm_phase<Epi, pg8::StaticOrder, false>((PG8_LAS unsigned char*)shm, g, S, E, nullptr);
}

DI void norm_rows(const float* xin_p, const float* xin_s, const bf16_t* raw, const float* part, int nsplit, const float* gpost, const float* gnext, float* yout_p, float* yout_s, bf16_t* H,
                  int row_lo, int row_hi, int wblk, int nwblk, bool spread = false, const bf16_t* xb = nullptr, bf16_t* yb = nullptr) {
    const int lane = tid_opaque() & 63, wid = tid_opaque() >> 6;
    f32x4 gpv[8], gnv[8];
#pragma unroll
    for (int i = 0; i < 8; ++i) {
        gpv[i] = gpost ? *(const f32x4*)(gpost + (i * 64 + lane) * 4) : (f32x4){0.f, 0.f, 0.f, 0.f};
        gnv[i] = gnext ? *(const f32x4*)(gnext + (i * 64 + lane) * 4) : (f32x4){0.f, 0.f, 0.f, 0.f};
    }
    for (int row = row_lo + (spread ? wblk + wid * nwblk : wblk * 8 + wid); row < row_hi; row += nwblk * 8) {
        f32x4 xv[8];
        if (xb) {
#pragma unroll
            for (int i = 0; i < 8; ++i) { const u32x2 b = *(const u32x2*)(xb + (size_t)row * DM + (i * 64 + lane) * 4); xv[i][0] = bflo(b[0]); xv[i][1] = bfhi(b[0]); xv[i][2] = bflo(b[1]); xv[i][3] = bfhi(b[1]); }
        } else {
            const float* xi = row < NP ? xin_p + (size_t)row * DM : xin_s + (size_t)(row - NP) * DM;
#pragma unroll
            for (int i = 0; i < 8; ++i) xv[i] = *(const f32x4*)(xi + (i * 64 + lane) * 4);
        }
        if (raw) {
            f32x4 rv[8]; float ss = 0.f;
            if (row < NP) {
#pragma unroll
                for (int i = 0; i < 8; ++i) { const u32x2 rb = *(const u32x2*)(raw + (size_t)row * DM + (i * 64 + lane) * 4); rv[i][0] = bflo(rb[0]); rv[i][1] = bfhi(rb[0]); rv[i][2] = bflo(rb[1]); rv[i][3] = bfhi(rb[1]); }
            } else {
                const bf16_t* pr = (const bf16_t*)part + (size_t)(row - NP) * DM + lane * 4;
#pragma unroll
                for (int i = 0; i < 8; ++i) { const u32x2 b = *(const u32x2*)(pr + i * 256); rv[i][0] = bflo(b[0]); rv[i][1] = bfhi(b[0]); rv[i][2] = bflo(b[1]); rv[i][3] = bfhi(b[1]); }
#pragma unroll 4
                for (int s = 1; s < nsplit; ++s) {
                    u32x2 tv[8];
#pragma unroll
                    for (int i = 0; i < 8; ++i) tv[i] = *(const u32x2*)(pr + (size_t)s * 256 * DM + i * 256);
#pragma unroll
                    for (int i = 0; i < 8; ++i) { rv[i][0] += bflo(tv[i][0]); rv[i][1] += bfhi(tv[i][0]); rv[i][2] += bflo(tv[i][1]); rv[i][3] += bfhi(tv[i][1]); }
                }
            }
#pragma unroll
            for (int i = 0; i < 8; ++i) ss += rv[i][0] * rv[i][0] + rv[i][1] * rv[i][1] + rv[i][2] * rv[i][2] + rv[i][3] * rv[i][3];
            ss = wave_sum(ss); const float rs = rsqrtf(ss * (1.0f / DM) + EPS);
#pragma unroll
            for (int i = 0; i < 8; ++i) xv[i] += rv[i] * rs * gpv[i];
            if (yb) {
#pragma unroll
                for (int i = 0; i < 8; ++i) { u32x2 pk; pk[0] = pk2(xv[i][0], xv[i][1]); pk[1] = pk2(xv[i][2], xv[i][3]); *(u32x2*)(yb + (size_t)row * DM + (i * 64 + lane) * 4) = pk; }
            } else {
                float* yo = row < NP ? yout_p + (size_t)row * DM : yout_s + (size_t)(row - NP) * DM;
#pragma unroll
                for (int i = 0; i < 8; ++i) *(f32x4*)(yo + (i * 64 + lane) * 4) = xv[i];
            }
        }
        if (gnext) {
            float ss = 0.f;
#pragma unroll
            for (int i = 0; i < 8; ++i) ss += xv[i][0] * xv[i][0] + xv[i][1] * xv[i][1] + xv[i][2] * xv[i][2] + xv[i][3] * xv[i][3];
            ss = wave_sum(ss); const float rs = rsqrtf(ss * (1.0f / DM) + EPS);
#pragma unroll
            for (int i = 0; i < 8; ++i) {
                const f32x4 hv = xv[i] * rs * gnv[i];
                u32x2 pk; pk[0] = pk2(hv[0], hv[1]); pk[1] = pk2(hv[2], hv[3]);
                *(u32x2*)(H + (size_t)row * DM + (i * 64 + lane) * 4) = pk;
            }
        }
    }
}

constexpr int RG_IN = 18;
struct InOrder {
    pg8::StaticOrder so; int G, c;
    DI void init(int G_, int c_) { so.init(MT, 21 * 256, G_, c_); G = G_; c = c_; }
    DI bool next(int i, pg8::Unit& u) const {
        const int L = i * G + c;
        if (L < 693) { so.next(i, u); if (u.pn >= 8) u.pn += 4; return true; }
        const int L2 = L - 693;
        if (L2 < RG_IN * 4) { u.pm = L2 >> 2; u.pn = 8 + (L2 & 3); return true; }
        return false;
    }
    DI void a_ready(const pg8::Unit&) const {}
    DI void done(const pg8::Unit&) const {}
};

struct ConvTile { const float* src; bf16_t* dst; int ld, Kd, k0, n0, sc; };
DI ConvTile conv_tile(const Params& p, int t, int lane) {
    ConvTile c; const int l = t >= 3104 ? 1 : 0; int u = t - l * 3104; int nn;
    if (u < 800) { c.k0 = (u / 25) * 64; c.n0 = (u % 25) * 256; c.src = p.w_in + (size_t)l * DM * 6168; c.ld = 6168; c.dst = p.WinT + (size_t)l * NIN * DM; c.Kd = DM; nn = c.n0 + 4 * lane;
        c.sc = nn < 2048 ? nn : nn < 6144 ? nn + 16 : nn < 6160 ? nn - 4096 : nn < 6168 ? nn : -1; }
    else if ((u -= 800) < 256) { c.k0 = (u >> 3) * 64; c.n0 = (u & 7) * 256; c.src = p.w_out + (size_t)l * DM * DM; c.ld = DM; c.dst = p.WoutT + (size_t)l * DM * DM; c.Kd = DM; c.sc = c.n0 + 4 * lane; }
    else if ((u -= 256) < 1024) { c.k0 = (u >> 5) * 64; c.n0 = (u & 31) * 256; c.src = p.w_up + (size_t)l * DM * DFF; c.ld = DFF; c.dst = p.WupT + (size_t)l * DFF * DM; c.Kd = DM; c.sc = c.n0 + 4 * lane; }
    else { u -= 1024; c.k0 = (u >> 3) * 64; c.n0 = (u & 7) * 256; c.src = p.w_down + (size_t)l * DFF * DM; c.ld = DM; c.dst = p.WdownT + (size_t)l * DM * DFF; c.Kd = DFF; c.sc = c.n0 + 4 * lane; }
    return c;
}
DI void convert_weights(const Params& p, char* shm, int t_begin, int t_end, int t_stride) {
    const int tid = tid_opaque(), lane = tid & 63, wv = tid >> 6;
    int t = t_begin;
    if (t >= t_end) return;
    ConvTile c = conv_tile(p, t, lane);
    f32x4 v[8];
#pragma unroll
    for (int e = 0; e < 8; ++e) { v[e][0] = v[e][1] = v[e][2] = v[e][3] = 0.f; if (c.sc >= 0) v[e] = *(const f32x4*)(c.src + (size_t)(c.k0 + 8 * wv + e) * c.ld + c.sc); }
    for (;;) {
#pragma unroll
        for (int j = 0; j < 4; ++j) {
            u32x4 pk; pk[0] = pk2(v[0][j], v[1][j]); pk[1] = pk2(v[2][j], v[3][j]); pk[2] = pk2(v[4][j], v[5][j]); pk[3] = pk2(v[6][j], v[7][j]);
            *(u32x4*)(shm + (4 * lane + j) * 144 + wv * 16) = pk;
        }
        const ConvTile cur = c;
        const int tn = t + t_stride; const bool more = tn < t_end;
        if (more) { c = conv_tile(p, tn, lane);
#pragma unroll
            for (int e = 0; e < 8; ++e) { v[e][0] = v[e][1] = v[e][2] = v[e][3] = 0.f; if (c.sc >= 0) v[e] = *(const f32x4*)(c.src + (size_t)(c.k0 + 8 * wv + e) * c.ld + c.sc); } }
        __syncthreads();
#pragma unroll
        for (int i = 0; i < 4; ++i) {
            const int q = tid + 512 * i, row = q >> 3, ch = q & 7;
            *(u32x4*)(cur.dst + (size_t)(cur.n0 + row) * cur.Kd + cur.k0 + ch * 8) = *(const u32x4*)(shm + row * 144 + ch * 16);
        }
        __syncthreads();
        if (!more) break;
        t = tn;
    }
}

DI void phase0(const Params& p, char* shm) {
    if (blockIdx.x == 0 && tid_opaque() < 32) p.ctr[tid_opaque()] = 0u;
    convert_weights(p, shm, (int)blockIdx.x, 6208, (int)gridDim.x);
    norm_rows(p.x_prompt, p.x_sample, nullptr, nullptr, 0, nullptr, p.g_mix_pre, nullptr, nullptr, p.H, 0, MT, (int)blockIdx.x, (int)gridDim.x);
}

template <class F>
DI void block_cumsum(int n, F load, float* cs, float* wt) {
    const int tid = tid_opaque(), lane = tid & 63, wid = tid >> 6;
    float v[5]; float s = 0.f;
#pragma unroll
    for (int j = 0; j < 5; ++j) { const int idx = tid * 5 + j; v[j] = idx < n ? load(idx) : 0.f; s += v[j]; }
    float inc = s;
#pragma unroll
    for (int o = 1; o < 64; o <<= 1) { const float t = __shfl_up(inc, o); if (lane >= o) inc += t; }
    if (lane == 63) wt[wid] = inc;
    __syncthreads();
    float run = inc - s;
    for (int w = 0; w < wid; ++w) run += wt[w];
#pragma unroll
    for (int j = 0; j < 5; ++j) { const int idx = tid * 5 + j; run += v[j]; if (idx < n) cs[idx] = run * LOG2E; }
    __syncthreads();
}

template <int NKT>
DI void fox_tile(const bf16_t* Ks, int ldk, const bf16_t* Vt, int ldv, const float* csl, int kpos0, int qpos, float cql,
                 const bf16x8 (&qf)[8], f32x16 (&o)[4], float& m, float& l, int r, int hh, bool need_mask) {
    constexpr float SC2 = 0.08838834764831845f * LOG2E;
    f32x16 x[NKT];
#pragma unroll
    for (int t2 = 0; t2 < NKT; ++t2) {
#pragma unroll
        for (int i = 0; i < 16; ++i) x[t2][i] = 0.f;
#pragma unroll
        for (int ks = 0; ks < 8; ++ks) { const bf16x8 a = *(const bf16x8*)(Ks + (t2 * 32 + r) * ldk + 16 * ks + 8 * hh); x[t2] = MFMA32(a, qf[ks], x[t2]); }
    }
    float mx = -1e30f;
#pragma unroll
    for (int t2 = 0; t2 < NKT; ++t2)
#pragma unroll
        for (int i = 0; i < 16; ++i) {
            const int kl = t2 * 32 + crow(i, hh);
            const f32x4 c4 = *(const f32x4*)(csl + t2 * 32 + 8 * (i >> 2) + 4 * hh);
            float v = fmaf(x[t2][i], SC2, cql - c4[i & 3]);
            if (need_mask) v = (kpos0 + kl <= qpos) ? v : -1e30f;
            x[t2][i] = v; mx = fmaxf(mx, v);
        }
    mx = fmaxf(mx, __shfl_xor(mx, 32));
    const float mn = fmaxf(m, mx), alpha = __builtin_amdgcn_exp2f(m - mn);
    m = mn;
    float ls = 0.f;
#pragma unroll
    for (int t2 = 0; t2 < NKT; ++t2)
#pragma unroll
        for (int i = 0; i < 16; ++i) { const float pv = __builtin_amdgcn_exp2f(x[t2][i] - mn); x[t2][i] = pv; ls += pv; }
    l = l * alpha + ls;
    if (__builtin_amdgcn_ballot_w64(alpha != 1.0f) != 0ull) {
#pragma unroll
        for (int dt = 0; dt < 4; ++dt)
#pragma unroll
            for (int i = 0; i < 16; ++i) o[dt][i] *= alpha;
    }
#pragma unroll
    for (int t2 = 0; t2 < NKT; ++t2)
#pragma unroll
        for (int s = 0; s < 2; ++s) {
            u32x4 pp; pp[0] = pk2(x[t2][8 * s + 0], x[t2][8 * s + 1]); pp[1] = pk2(x[t2][8 * s + 2], x[t2][8 * s + 3]);
            pp[2] = pk2(x[t2][8 * s + 4], x[t2][8 * s + 5]); pp[3] = pk2(x[t2][8 * s + 6], x[t2][8 * s + 7]);
            const bf16x8 pf = __builtin_bit_cast(bf16x8, pp);
#pragma unroll
            for (int dt = 0; dt < 4; ++dt) {
                const bf16_t* vp = Vt + (dt * 32 + r) * ldv + t2 * 32 + 16 * s + 4 * hh;
                const s16x4 lo = *(const s16x4*)vp, hi = *(const s16x4*)(vp + 8);
                const bf16x8 a = __builtin_shufflevector(lo, hi, 0, 1, 2, 3, 4, 5, 6, 7);
                o[dt] = MFMA32(a, pf, o[dt]);
            }
        }
}

DI void fox_prompt_item(const Params& p, int l, int b, int h, int qb, char* shm) {
    bf16_t* Ks = (bf16_t*)shm; bf16_t* Vt = (bf16_t*)(shm + 17408); float* cs = (float*)(shm + 143360); float* wt = (float*)(shm + 151680);
    const int tid = tid_opaque(), wid = tid >> 6, lane = tid & 63, r = lane & 31, hh = lane >> 5;
    const int nkeys = (qb + 1) * 256;
    const float* lf = p.EX + ((size_t)b * 2048) * 32 + 16 + h; const float fb = p.b_fox_f[l * 8 + h];
    block_cumsum(nkeys, [&](int i) { return logsig(lf[(size_t)i * 32] + fb); }, cs, wt);
    const int qpos = qb * 256 + wid * 32 + r; const size_t qrow = (size_t)b * 2048 + qpos;
    bf16x8 qf[8];
    { const bf16_t* zq = p.Z + qrow * NZ + 3072 + h * 128;
#pragma unroll
      for (int ks = 0; ks < 8; ++ks) qf[ks] = *(const bf16x8*)(zq + 16 * ks + 8 * hh); }
    const float cql = cs[qpos];
    f32x16 o[4];
#pragma unroll
    for (int dt = 0; dt < 4; ++dt)
#pragma unroll
        for (int i = 0; i < 16; ++i) o[dt][i] = 0.f;
    float m = -1e30f, lsum = 0.f;
    const int nt = (qb + 1) * 4;
    const bf16_t* zk = p.Z + (size_t)b * 2048 * NZ + 4096 + h * 128; const bf16_t* zv = zk + 1024;
    int krow_[2], kc8[2], vrow[2], vc8[2];
#pragma unroll
    for (int i = 0; i < 2; ++i) { const int q = tid + 512 * i; krow_[i] = q >> 4; kc8[i] = (q & 15) * 8; const int wv = q >> 6, ln = q & 63; vrow[i] = (wv & 3) * 16 + (ln & 15); vc8[i] = ((wv >> 2) * 4 + (ln >> 4)) * 8; }
    u32x4 kreg[2], vreg[2];
#pragma unroll
    for (int i = 0; i < 2; ++i) { kreg[i] = *(const u32x4*)(zk + (size_t)((nt - 1) * 64 + krow_[i]) * NZ + kc8[i]); vreg[i] = *(const u32x4*)(zv + (size_t)((nt - 1) * 64 + vrow[i]) * NZ + vc8[i]); }
    const int qmaxw = qb * 256 + wid * 32 + 31, qminw = qb * 256 + wid * 32;
    for (int kt = nt - 1; kt >= 0; --kt) {
        __syncthreads();
#pragma unroll
        for (int i = 0; i < 2; ++i) {
            *(u32x4*)(Ks + krow_[i] * 136 + kc8[i]) = kreg[i];
#pragma unroll
            for (int e = 0; e < 4; ++e) { const unsigned w = vreg[i][e]; Vt[(vc8[i] + 2 * e) * 68 + vrow[i]] = (bf16_t)(w & 0xffffu); Vt[(vc8[i] + 2 * e + 1) * 68 + vrow[i]] = (bf16_t)(w >> 16); }
        }
        __syncthreads();
        if (kt > 0) {
#pragma unroll
            for (int i = 0; i < 2; ++i) { kreg[i] = *(const u32x4*)(zk + (size_t)((kt - 1) * 64 + krow_[i]) * NZ + kc8[i]); vreg[i] = *(const u32x4*)(zv + (size_t)((kt - 1) * 64 + vrow[i]) * NZ + vc8[i]); }
        }
        if (kt * 64 <= qmaxw) fox_tile<2>(Ks, 136, Vt, 68, cs + kt * 64, kt * 64, qpos, cql, qf, o, m, lsum, r, hh, kt * 64 + 63 > qminw);
    }
    const float lt = lsum + __shfl_xor(lsum, 32); const float inv = 1.0f / lt;
    bf16_t* mo = p.MRG + qrow * DM + 1024 + h * 128;
#pragma unroll
    for (int dt = 0; dt < 4; ++dt)
#pragma unroll
        for (int g = 0; g < 4; ++g) {
            u32x2 pk; pk[0] = pk2(o[dt][4 * g] * inv, o[dt][4 * g + 1] * inv); pk[1] = pk2(o[dt][4 * g + 2] * inv, o[dt][4 * g + 3] * inv);
            *(u32x2*)(mo + dt * 32 + 8 * g + 4 * hh) = pk;
        }
}

DI float logsig_fast(float x) { return fminf(x, 0.f) - 0.6931471805599453f * __builtin_amdgcn_logf(1.0f + __builtin_amdgcn_exp2f(-fabsf(x) * LOG2E)); }
DI float exp_fast(float x) { return __builtin_amdgcn_exp2f(x * LOG2E); }

DI void gla_a_item(const Params& p, int l, int it, char* shm) {
    bf16_t* Qi = (bf16_t*)shm; bf16_t* Ki = (bf16_t*)(shm + 17408); bf16_t* Ket = (bf16_t*)(shm + 34816); bf16_t* At = (bf16_t*)(shm + 53248);
    float* dec = (float*)(shm + 62464); float* tot = (float*)(shm + 62976); bf16_t* Vt = (bf16_t*)(shm + 65024);
    float* glr = (float*)(shm + 101888); bf16_t* Qraw = (bf16_t*)(shm + 105984); bf16_t* Kraw = (bf16_t*)(shm + 122368);
    const int tid = tid_opaque(), wid = tid >> 6, lane = tid & 63, r = lane & 31, hh = lane >> 5;
    const int grp = it >= 512 ? 1 : 0;
    const int h = grp ? (it & 3) : ((it >> 5) & 3);
    const int nvalid = grp ? 32 : 64;
    const size_t rowc = grp ? (size_t)NP + (size_t)((it - 512) >> 2) * 32 : (size_t)(it >> 7) * 2048 + (size_t)(it & 31) * 64;
    const int d = tid & 127, sg = tid >> 7;
    float w2[16];
#pragma unroll
    for (int k = 0; k < 16; ++k) w2[k] = p.w_gate_up[((size_t)l * 16 + k) * 512 + h * 128 + d];
    const float bias = p.b_gate[(size_t)l * 512 + h * 128 + d];
    if (tid < 256) {
        const int s = tid >> 2, part = tid & 3; f32x4 v; v[0] = v[1] = v[2] = v[3] = 0.f;
        if (s < nvalid) v = *(const f32x4*)(p.EX + (rowc + s) * 32 + part * 4);
        *(f32x4*)(glr + s * 16 + part * 4) = v;
    }
#pragma unroll
    for (int i = 0; i < 2; ++i) {
        const int q = tid + 512 * i, row = q >> 4, c8 = (q & 15) * 8;
        u32x4 qv, kv; qv[0] = qv[1] = qv[2] = qv[3] = 0u; kv = qv;
        if (row < nvalid) { const bf16_t* zr = p.Z + (rowc + row) * NZ + h * 128 + c8; qv = *(const u32x4*)zr; kv = *(const u32x4*)(zr + 512); }
        *(u32x4*)(Qraw + row * 128 + c8) = qv; *(u32x4*)(Kraw + row * 128 + c8) = kv;
    }
    __syncthreads();
    float gv[16]; float cum = 0.f;
#pragma unroll
    for (int i = 0; i < 16; ++i) {
        const int s = sg * 16 + i; float gl = 0.f;
        if (s < nvalid) {
            const float* e = glr + s * 16; float x = bias;
#pragma unroll
            for (int k4 = 0; k4 < 4; ++k4) { const f32x4 ev = *(const f32x4*)(e + 4 * k4); x += ev[0] * w2[4 * k4] + ev[1] * w2[4 * k4 + 1] + ev[2] * w2[4 * k4 + 2] + ev[3] * w2[4 * k4 + 3]; }
            gl = logsig_fast(x) * 0.0625f;
        }
        cum += gl; gv[i] = cum;
    }
    tot[sg * 128 + d] = cum;
#pragma unroll
    for (int i = 0; i < 4; ++i) {
        const int q = tid + 512 * i, wv = q >> 6, ln = q & 63, s = (wv & 3) * 16 + (ln & 15), pc = (wv >> 2) * 4 + (ln >> 4);
        u32x4 vv; vv[0] = vv[1] = vv[2] = vv[3] = 0u;
        if (s < nvalid) vv = *(const u32x4*)(p.Z + (rowc + s) * NZ + 1024 + h * 256 + pc * 8);
#pragma unroll
        for (int e = 0; e < 4; ++e) { Vt[(pc * 8 + 2 * e) * 72 + s] = (bf16_t)(vv[e] & 0xffffu); Vt[(pc * 8 + 2 * e + 1) * 72 + s] = (bf16_t)(vv[e] >> 16); }
    }
    __syncthreads();
    float off = 0.f;
    for (int g = 0; g < sg; ++g) off += tot[g * 128 + d];
    const float blast = tot[d] + tot[128 + d] + tot[256 + d] + tot[384 + d];
    {
        float kev[16];
#pragma unroll
        for (int i = 0; i < 16; ++i) {
            const int s = sg * 16 + i; const float bb = off + gv[i]; float q = 0.f, k = 0.f;
            q = bf2f(Qraw[s * 128 + d]); k = bf2f(Kraw[s * 128 + d]);
            const bf16_t qi = f2bf(q * exp_fast(bb));
            Qi[s * 136 + d] = qi; Ki[s * 136 + d] = f2bf(k * exp_fast(-bb)); kev[i] = k * exp_fast(blast - bb);
        }
        u32x4 p0, p1;
        p0[0] = pk2(kev[0], kev[1]); p0[1] = pk2(kev[2], kev[3]); p0[2] = pk2(kev[4], kev[5]); p0[3] = pk2(kev[6], kev[7]);
        p1[0] = pk2(kev[8], kev[9]); p1[1] = pk2(kev[10], kev[11]); p1[2] = pk2(kev[12], kev[13]); p1[3] = pk2(kev[14], kev[15]);
        *(u32x4*)(Ket + d * 72 + sg * 16) = p0; *(u32x4*)(Ket + d * 72 + sg * 16 + 8) = p1;
        if (sg == 0) p.DEC[(size_t)it * 128 + d] = exp_fast(blast);
    }
    __syncthreads();
#pragma unroll
    for (int i = 0; i < 2; ++i) {
        const int q = tid + 512 * i, row = q >> 4, c8 = (q & 15) * 8;
        if (row < nvalid) *(u32x4*)(p.QI + (rowc + row) * 512 + h * 128 + c8) = *(const u32x4*)(Qi + row * 136 + c8);
    }
    if (wid < 3) {
        const int si = wid == 2 ? 1 : 0, ci = wid >= 1 ? 1 : 0;
        f32x16 x;
#pragma unroll
        for (int i = 0; i < 16; ++i) x[i] = 0.f;
#pragma unroll
        for (int ks = 0; ks < 8; ++ks) {
            const bf16x8 a = *(const bf16x8*)(Ki + (si * 32 + r) * 136 + 16 * ks + 8 * hh);
            const bf16x8 bq = *(const bf16x8*)(Qi + (ci * 32 + r) * 136 + 16 * ks + 8 * hh);
            x = MFMA32(a, bq, x);
        }
        const int c = ci * 32 + r;
#pragma unroll
        for (int g = 0; g < 4; ++g) {
            float v[4];
#pragma unroll
            for (int e = 0; e < 4; ++e) { const int s = si * 32 + 8 * g + 4 * hh + e; v[e] = s <= c ? x[4 * g + e] : 0.f; }
            u32x2 pk; pk[0] = pk2(v[0], v[1]); pk[1] = pk2(v[2], v[3]);
            *(u32x2*)(At + c * 72 + si * 32 + 8 * g + 4 * hh) = pk;
        }
    }
    __syncthreads();
    {
        bf16x8 av[4];
#pragma unroll
        for (int ks = 0; ks < 4; ++ks) av[ks] = *(const bf16x8*)(Vt + (wid * 32 + r) * 72 + 16 * ks + 8 * hh);
#pragma unroll
        for (int ci = 0; ci < 2; ++ci) {
            if (ci * 32 < nvalid) {
                f32x16 oa;
#pragma unroll
                for (int i = 0; i < 16; ++i) oa[i] = 0.f;
#pragma unroll
                for (int ks = 0; ks < 4; ++ks) {
                    if (ks < (ci ? 4 : 2)) { const bf16x8 bq = *(const bf16x8*)(At + (ci * 32 + r) * 72 + 16 * ks + 8 * hh); oa = MFMA32(av[ks], bq, oa); }
                }
                bf16_t* og = (bf16_t*)p.OG + (rowc + ci * 32 + r) * 1024 + h * 256 + wid * 32 + 4 * hh;
#pragma unroll
                for (int g = 0; g < 4; ++g) { u32x2 pk; pk[0] = pk2(oa[4 * g], oa[4 * g + 1]); pk[1] = pk2(oa[4 * g + 2], oa[4 * g + 3]); *(u32x2*)(og + 8 * g) = pk; }
            }
        }
        bf16_t* kvt = (bf16_t*)p.KVT + (size_t)it * 32768;
#pragma unroll
        for (int di = 0; di < 4; ++di) {
            f32x16 acc;
#pragma unroll
            for (int i = 0; i < 16; ++i) acc[i] = 0.f;
#pragma unroll
            for (int ks = 0; ks < 4; ++ks) { const bf16x8 bq = *(const bf16x8*)(Ket + (di * 32 + r) * 72 + 16 * ks + 8 * hh); acc = MFMA32(bq, av[ks], acc); }
#pragma unroll
            for (int g = 0; g < 4; ++g) { u32x2 pk; pk[0] = pk2(acc[4 * g], acc[4 * g + 1]); pk[1] = pk2(acc[4 * g + 2], acc[4 * g + 3]); *(u32x2*)(kvt + (wid * 32 + r) * 128 + di * 32 + 8 * g + 4 * hh) = pk; }
        }
    }
}

DI void gla_scan(const Params& p, int l) {
    const int tid = tid_opaque();
    for (int idx = blockIdx.x * 512 + tid; idx < MT * 8; idx += gridDim.x * 512) {
        const int row = idx >> 3, hd = idx & 7; const float lf = logsig(p.EX[(size_t)row * 32 + 16 + hd] + p.b_fox_f[l * 8 + hd]);
        if (row < NP) p.out[O_LFP + ((size_t)l * NP + row) * 8 + hd] = lf; else p.out[O_LFS + ((size_t)l * NS + row - NP) * 8 + hd] = lf;
    }
    for (int t = blockIdx.x; t < 768; t += gridDim.x) {
        const int grp = t >= 256 ? 1 : 0, u = grp ? t - 256 : t, seq = u >> 4, vt = u & 15;
        const int nch = grp ? 1 : 32, item0 = grp ? 512 + seq : seq * 32;
        const int v = vt * 16 + (tid & 15), d0 = (tid >> 4) * 4;
        float S[4];
        if (grp) {
            const float* sin = p.state_gla + (((size_t)l * 32 + seq) * 128 + d0) * 256 + v;
#pragma unroll
            for (int j = 0; j < 4; ++j) S[j] = sin[(size_t)j * 256];
        } else {
#pragma unroll
            for (int j = 0; j < 4; ++j) S[j] = 0.f;
        }
#pragma unroll 8
        for (int n = 0; n < nch; ++n) {
            const size_t it = (size_t)(item0 + n);
            u32x2 pk; pk[0] = pk2(S[0], S[1]); pk[1] = pk2(S[2], S[3]);
            *(u32x2*)(p.SS + it * 32768 + (size_t)v * 128 + d0) = pk;
            const u32x2 kb = *(const u32x2*)((const bf16_t*)p.KVT + it * 32768 + (size_t)v * 128 + d0); const f32x4 c0 = *(const f32x4*)(p.DEC + it * 128 + d0);
            f32x4 k0; k0[0] = bflo(kb[0]); k0[1] = bfhi(kb[0]); k0[2] = bflo(kb[1]); k0[3] = bfhi(kb[1]);
#pragma unroll
            for (int j = 0; j < 4; ++j) S[j] = c0[j] * S[j] + k0[j];
        }
        float* so = (grp ? p.out + O_STS + (((size_t)l * 32 + seq) * 128 + d0) * 256 : p.out + O_STP + (((size_t)l * 16 + seq) * 128 + d0) * 256) + v;
#pragma unroll
        for (int j = 0; j < 4; ++j) so[(size_t)j * 256] = S[j];
    }
}

DI void gla_c_stage(const Params& p, int l, char* shm) {
    const int tid = tid_opaque(), wid = tid >> 6, lane = tid & 63, r = lane & 31, hh = lane >> 5;
    for (int wt = wid * (int)gridDim.x + (int)blockIdx.x; wt < 1088; wt += 8 * (int)gridDim.x) {
        const int it = wt >> 1, ci = wt & 1;
        const int grp = it >= 512 ? 1 : 0;
        if (grp && ci) continue;
        const int h = grp ? (it & 3) : ((it >> 5) & 3);
        const size_t rowc = grp ? (size_t)NP + (size_t)((it - 512) >> 2) * 32 : (size_t)(it >> 7) * 2048 + (size_t)(it & 31) * 64;
        const size_t row = rowc + ci * 32 + r;
        bf16x8 bq[8];
#pragma unroll
        for (int ks = 0; ks < 8; ++ks) bq[ks] = *(const bf16x8*)(p.QI + row * 512 + h * 128 + 16 * ks + 8 * hh);
        f32x16 acc[8];
        float ss = 0.f;
#pragma unroll
        for (int vt = 0; vt < 8; ++vt) {
            const bf16_t* og = (const bf16_t*)p.OG + row * 1024 + h * 256 + vt * 32 + 4 * hh;
#pragma unroll
            for (int g = 0; g < 4; ++g) { const u32x2 v = *(const u32x2*)(og + 8 * g); acc[vt][4 * g] = bflo(v[0]); acc[vt][4 * g + 1] = bfhi(v[0]); acc[vt][4 * g + 2] = bflo(v[1]); acc[vt][4 * g + 3] = bfhi(v[1]); }
            const bf16_t* ssp = p.SS + (size_t)it * 32768 + (size_t)(vt * 32 + r) * 128 + 8 * hh;
#pragma unroll
            for (int ks = 0; ks < 8; ++ks) { const bf16x8 a = *(const bf16x8*)(ssp + 16 * ks); acc[vt] = MFMA32(a, bq[ks], acc[vt]); }
#pragma unroll
            for (int i = 0; i < 16; ++i) ss += acc[vt][i] * acc[vt][i];
        }
        ss += __shfl_xor(ss, 32);
        const float rs = rsqrtf(ss * (1.0f / 256.0f) + EPS);
#pragma unroll
        for (int vt = 0; vt < 8; ++vt) {
            const int vc = h * 256 + vt * 32 + 4 * hh;
#pragma unroll
            for (int g = 0; g < 4; ++g) {
                const f32x4 gn = *(const f32x4*)(p.g_onorm + (size_t)l * 1024 + vc + 8 * g);
                const u32x2 rg = *(const u32x2*)(p.Z + row * NZ + 2048 + vc + 8 * g);
                const float r0 = bflo(rg[0]), r1 = bfhi(rg[0]), r2 = bflo(rg[1]), r3 = bfhi(rg[1]);
                const float o0 = acc[vt][4 * g] * rs * gn[0] * (r0 / (1.0f + exp_fast(-r0))), o1 = acc[vt][4 * g + 1] * rs * gn[1] * (r1 / (1.0f + exp_fast(-r1)));
                const float o2 = acc[vt][4 * g + 2] * rs * gn[2] * (r2 / (1.0f + exp_fast(-r2))), o3 = acc[vt][4 * g + 3] * rs * gn[3] * (r3 / (1.0f + exp_fast(-r3)));
                u32x2 pk; pk[0] = pk2(o0, o1); pk[1] = pk2(o2, o3);
                *(u32x2*)(p.MRG + row * DM + vc + 8 * g) = pk;
            }
        }
    }
}

DI void fox_sample_item(const Params& p, int l, int b, int h, int sp, char* shm) {
    float* cs = (float*)(shm + 143360); float* wt = (float*)(shm + 151680);
    const int tid = tid_opaque(), wid = tid >> 6, lane = tid & 63, r = lane & 31, hh = lane >> 5;
    const float* lfc = p.cache_logf + ((size_t)(l * 8 + b) * 2048) * 8 + h;
    const float* lfn = p.EX + ((size_t)NP + b * 32) * 32 + 16 + h; const float fb = p.b_fox_f[l * 8 + h];
    block_cumsum(2080, [&](int i) { return i < 2048 ? lfc[(size_t)i * 8] : logsig(lfn[(size_t)(i - 2048) * 32] + fb); }, cs, wt);
    const int qpos = 2048 + r; const size_t qrow = (size_t)NP + b * 32 + r;
    bf16x8 qf[8];
    { const bf16_t* zq = p.Z + qrow * NZ + 3072 + h * 128;
#pragma unroll
      for (int ks = 0; ks < 8; ++ks) qf[ks] = *(const bf16x8*)(zq + 16 * ks + 8 * hh); }
    const float cql = cs[qpos];
    f32x16 o[4];
#pragma unroll
    for (int dt = 0; dt < 4; ++dt)
#pragma unroll
        for (int i = 0; i < 16; ++i) o[dt][i] = 0.f;
    float m = -1e30f, lsum = 0.f;
    bf16_t* Ks = (bf16_t*)(shm + wid * 17920); bf16_t* Vt = (bf16_t*)(shm + wid * 17920 + 8704);
    const int jend = sp * 17 + 17 < 65 ? sp * 17 + 17 : 65;
    for (int j = sp * 17 + wid; j < jend; j += 8) {
        const float* srcK = j < 64 ? p.cache_k + (((size_t)(l * 8 + b) * 2048 + (size_t)j * 32) * 8 + h) * 128 : p.out + O_KS + (((size_t)(l * 8 + b) * 32) * 8 + h) * 128;
        const float* srcV = j < 64 ? p.cache_v + (((size_t)(l * 8 + b) * 2048 + (size_t)j * 32) * 8 + h) * 128 : p.out + O_VS + (((size_t)(l * 8 + b) * 32) * 8 + h) * 128;
        {
            const int prow = lane >> 5, pc4 = (lane & 31) * 4;
            f32x4 kr[16], va[4];
#pragma unroll
            for (int i = 0; i < 16; ++i) kr[i] = *(const f32x4*)(srcK + (size_t)(2 * i + prow) * 1024 + pc4);
#pragma unroll
            for (int i = 0; i < 4; ++i) va[i] = *(const f32x4*)(srcV + (size_t)(2 * i + prow) * 1024 + pc4);
#pragma unroll
            for (int i = 0; i < 16; ++i) { u32x2 pk; pk[0] = pk2(kr[i][0], kr[i][1]); pk[1] = pk2(kr[i][2], kr[i][3]); *(u32x2*)(Ks + (2 * i + prow) * 136 + pc4) = pk; }
            asm volatile("" ::: "memory");
            f32x4 vb[12];
#pragma unroll
            for (int i = 0; i < 12; ++i) vb[i] = *(const f32x4*)(srcV + (size_t)(2 * (i + 4) + prow) * 1024 + pc4);
#pragma unroll
            for (int i = 0; i < 4; ++i) {
#pragma unroll
                for (int e = 0; e < 4; ++e) Vt[(pc4 + e) * 36 + 2 * i + prow] = f2bf(va[i][e]);
            }
#pragma unroll
            for (int i = 0; i < 12; ++i) {
#pragma unroll
                for (int e = 0; e < 4; ++e) Vt[(pc4 + e) * 36 + 2 * (i + 4) + prow] = f2bf(vb[i][e]);
            }
        }
        fox_tile<1>(Ks, 136, Vt, 36, cs + j * 32, j * 32, qpos, cql, qf, o, m, lsum, r, hh, j == 64);
    }
    const float lt = lsum + __shfl_xor(lsum, 32);
    __syncthreads();
    float* ml = wt;
    if (hh == 0) { ml[(wid * 32 + r) * 2] = m; ml[(wid * 32 + r) * 2 + 1] = lt; }
    __syncthreads();
    float M = -1e30f;
#pragma unroll
    for (int w = 0; w < 8; ++w) M = fmaxf(M, ml[(w * 32 + r) * 2]);
    float L = 0.f;
#pragma unroll
    for (int w = 0; w < 8; ++w) L += __builtin_amdgcn_exp2f(ml[(w * 32 + r) * 2] - M) * ml[(w * 32 + r) * 2 + 1];
    const float f = __builtin_amdgcn_exp2f(m - M);
    float* ow = (float*)shm + wid * (32 * 132);
#pragma unroll
    for (int dt = 0; dt < 4; ++dt)
#pragma unroll
        for (int g = 0; g < 4; ++g) {
            f32x4 v; v[0] = o[dt][4 * g] * f; v[1] = o[dt][4 * g + 1] * f; v[2] = o[dt][4 * g + 2] * f; v[3] = o[dt][4 * g + 3] * f;
            *(f32x4*)(ow + r * 132 + dt * 32 + 8 * g + 4 * hh) = v;
        }
    const int slot = ((b * 8 + h) * 4 + sp);
    if (wid == 0 && hh == 0) { p.FSML[(size_t)(slot * 32 + r) * 2] = M; p.FSML[(size_t)(slot * 32 + r) * 2 + 1] = L; }
    __syncthreads();
    {
        const int q = tid >> 4, d8 = (tid & 15) * 8; float acc[8];
#pragma unroll
        for (int e = 0; e < 8; ++e) acc[e] = 0.f;
#pragma unroll
        for (int w = 0; w < 8; ++w) {
            const float* src = (const float*)shm + w * (32 * 132) + q * 132 + d8;
            const f32x4 a = *(const f32x4*)src, c = *(const f32x4*)(src + 4);
#pragma unroll
            for (int e = 0; e < 4; ++e) { acc[e] += a[e]; acc[4 + e] += c[e]; }
        }
        float* dst = p.FSO + ((size_t)slot * 32 + q) * 128 + d8;
        f32x4 v0, v1; v0[0] = acc[0]; v0[1] = acc[1]; v0[2] = acc[2]; v0[3] = acc[3]; v1[0] = acc[4]; v1[1] = acc[5]; v1[2] = acc[6]; v1[3] = acc[7];
        *(f32x4*)dst = v0; *(f32x4*)(dst + 4) = v1;
    }
}

DI void fox_sample_combine(const Params& p) {
    for (int idx = blockIdx.x * 512 + tid_opaque(); idx < 64 * 32 * 16; idx += gridDim.x * 512) {
        const int d8 = (idx & 15) * 8, q = (idx >> 4) & 31, bh = idx >> 9;
        float ms[4], ls[4], M = -1e30f;
#pragma unroll
        for (int s = 0; s < 4; ++s) { ms[s] = p.FSML[(size_t)((bh * 4 + s) * 32 + q) * 2]; ls[s] = p.FSML[(size_t)((bh * 4 + s) * 32 + q) * 2 + 1]; M = fmaxf(M, ms[s]); }
        float L = 0.f, acc[8];
#pragma unroll
        for (int e = 0; e < 8; ++e) acc[e] = 0.f;
#pragma unroll
        for (int s = 0; s < 4; ++s) {
            const float w = __builtin_amdgcn_exp2f(ms[s] - M); L += w * ls[s];
            const float* src = p.FSO + ((size_t)(bh * 4 + s) * 32 + q) * 128 + d8;
            const f32x4 a = *(const f32x4*)src, c = *(const f32x4*)(src + 4);
#pragma unroll
            for (int e = 0; e < 4; ++e) { acc[e] += w * a[e]; acc[4 + e] += w * c[e]; }
        }
        const float inv = 1.0f / L;
        u32x4 pk; pk[0] = pk2(acc[0] * inv, acc[1] * inv); pk[1] = pk2(acc[2] * inv, acc[3] * inv); pk[2] = pk2(acc[4] * inv, acc[5] * inv); pk[3] = pk2(acc[6] * inv, acc[7] * inv);
        *(u32x4*)(p.MRG + ((size_t)NP + (bh >> 3) * 32 + q) * DM + 1024 + (bh & 7) * 128 + d8) = pk;
    }
}

DI int pop_item(unsigned* ctr, char* shm) {
    volatile int* sitem = (volatile int*)(shm + LDS_ITEM_OFF);
    __syncthreads();
    if (tid_opaque() == 0) *sitem = (int)atomicAdd(ctr, 1u);
    __syncthreads();
    return *sitem;
}
template <int WHICH>
DI void mixer_phase(const Params& p, int l, char* shm, int coff) {
    if constexpr (WHICH & 1) for (;;) {
        const int j = pop_item(p.ctr + coff + l * 4 + 1, shm);
        if (j >= 256) break;
        fox_prompt_item(p, l, (j & 31) >> 3, j & 7, 7 - (j >> 5), shm);
    }
    if constexpr (WHICH == 7) for (;;) {
        const int j = pop_item(p.ctr + 16 + l, shm);
        if (j >= (33 - RG_IN) * 4) break;
        EpiIn E; E.Z = p.Z; E.EX = p.EX; E.row_base = RG_IN * 256; E.pn_base = 8; E.outk_p = E.outv_p = E.outk_s = E.outv_s = nullptr;
        run_gemm(shm, p.H + (size_t)RG_IN * 256 * DM, p.WinT + (size_t)l * NIN * DM + (size_t)2048 * DM, (33 - RG_IN) * 256, 1024, DM, DM, DM, 1, E, (33 - RG_IN) * 4, j);
    }
    if constexpr (WHICH & 2) for (;;) {
        const int j = pop_item(p.ctr + coff + l * 4 + 2, shm);
        if (j >= 256) break;
        fox_sample_item(p, l, j >> 5, (j >> 2) & 7, j & 3, shm);
    }
    if constexpr (WHICH & 4) for (;;) {
        const int item = pop_item(p.ctr + coff + l * 4 + 0, shm);
        if (item >= 544) break;
        gla_a_item(p, l, item, shm);
    }
}

constexpr int NPHASE = 17;
constexpr int SPLIT_OUT = 8, SPLIT_DOWN = 16;
template <int S>
DI void run_stage(const Params& p, int l, char* shm) {
    float* yp = p.out + O_YP; float* ys = p.out + O_YS;
    if constexpr (S == 8) { phase0(p, shm); }
    if constexpr (S == 0) { EpiIn E; E.Z = p.Z; E.EX = p.EX; E.row_base = 0; E.pn_base = 0; E.outk_p = p.out + O_KP + (size_t)l * NP * 1024; E.outv_p = p.out + O_VP + (size_t)l * NP * 1024;
              E.outk_s = p.out + O_KS + (size_t)l * NS * 1024; E.outv_s = p.out + O_VS + (size_t)l * NS * 1024;
              pg8::Gemm g; g.A = p.H; g.Bt = p.WinT + (size_t)l * NIN * DM; g.M = MT; g.N = NIN; g.K = DM; g.lda = DM; g.ldb = DM; g.nct = NIN / 256; g.ksub = DM;
              InOrder S0; S0.init((int)gridDim.x, (int)blockIdx.x);
              pg8::gemm_phase<EpiIn, InOrder, false>((PG8_LAS unsigned char*)shm, g, S0, E, nullptr); }
    if constexpr (S == 1) mixer_phase<7>(p, l, shm, 0);
#if defined(PROBE) && PROBE >= 3 && PROBE <= 5
    if constexpr (S == 9) mixer_phase<(PROBE == 3 ? 1 : PROBE == 4 ? 2 : 4)>(p, l, shm, 8);
#endif
    if constexpr (S == 12) mixer_phase<7>(p, l, shm, 8);
    if constexpr (S == 2) { fox_sample_combine(p); gla_scan(p, l); }
    if constexpr (S == 10) gla_c_stage(p, l, shm);
    if constexpr (S == 3) { EpiRaw E; E.C = p.RAW; run_gemm(shm, p.MRG, p.WoutT + (size_t)l * DM * DM, NP, DM, DM, DM, DM, 1, E);
              EpiPart EP; EP.P = (bf16_t*)p.PART; run_gemm(shm, p.MRG + (size_t)NP * DM, p.WoutT + (size_t)l * DM * DM, NS, DM, DM / SPLIT_OUT, DM, DM, SPLIT_OUT, EP); }
    if constexpr (S == 14)
        norm_rows(l == 0 ? p.x_prompt : yp, l == 0 ? p.x_sample : ys, p.RAW, p.PART, SPLIT_OUT, p.g_mix_post + (size_t)l * DM, p.g_mlp_pre + (size_t)l * DM, yp, ys, p.H, NP, MT, (int)blockIdx.x, (int)gridDim.x, true, l == 0 ? nullptr : p.YB, p.YB);
    if constexpr (S == 4) {
        const int ng = (int)gridDim.x - 32;
        if ((int)blockIdx.x >= ng) { EpiUp E; E.U = p.U + (size_t)NP * DFF; run_gemm(shm, p.H + (size_t)NP * DM, p.WupT + (size_t)l * DFF * DM, NS, DFF, DM, DM, DM, 1, E, 32, (int)blockIdx.x - ng); }
        else norm_rows(l == 0 ? p.x_prompt : yp, l == 0 ? p.x_sample : ys, p.RAW, p.PART, SPLIT_OUT, p.g_mix_post + (size_t)l * DM, p.g_mlp_pre + (size_t)l * DM, yp, ys, p.H, 0, NP, (int)blockIdx.x, ng, false, l == 0 ? nullptr : p.YB, p.YB);
    }
    if constexpr (S == 5) { EpiUp E; E.U = p.U; run_gemm(shm, p.H, p.WupT + (size_t)l * DFF * DM, NP, DFF, DM, DM, DM, 1, E); }
    if constexpr (S == 6) { EpiRaw E; E.C = p.RAW; run_gemm(shm, p.U, p.WdownT + (size_t)l * DM * DFF, NP, DM, DFF, DFF, DFF, 1, E);
              EpiPart EP; EP.P = (bf16_t*)p.PART; run_gemm(shm, p.U + (size_t)NP * DFF, p.WdownT + (size_t)l * DM * DFF, NS, DM, DFF / SPLIT_DOWN, DFF, DFF, SPLIT_DOWN, EP); }
    if constexpr (S == 7) {
        const float* gn = l + 1 < 2 ? p.g_mix_pre + (size_t)(l + 1) * DM : nullptr;
        norm_rows(yp, ys, p.RAW, p.PART, SPLIT_DOWN, p.g_mlp_post + (size_t)l * DM, gn, yp, ys, p.H, NP, MT, (int)blockIdx.x, (int)gridDim.x, true, p.YB, l + 1 < 2 ? p.YB : nullptr);
        norm_rows(yp, ys, p.RAW, p.PART, SPLIT_DOWN, p.g_mlp_post + (size_t)l * DM, gn, yp, ys, p.H, 0, NP, (int)blockIdx.x, (int)gridDim.x, false, p.YB, l + 1 < 2 ? p.YB : nullptr);
    }
}

#if MEGA
DI Params load_params() {
    Params r{};
#if defined(__HIP_DEVICE_COMPILE__)
    const __attribute__((address_space(4))) unsigned long long* kp = (const __attribute__((address_space(4))) unsigned long long*)__builtin_amdgcn_kernarg_segment_ptr();
    asm volatile("" : "+s"(kp));
    unsigned long long* d = (unsigned long long*)&r;
#pragma unroll
    for (int i = 0; i < (int)(sizeof(Params) / 8); ++i) d[i] = kp[i];
#endif
    return r;
}
__global__ void __launch_bounds__(512, 2) k_mega(Params p_unused) {
    extern __shared__ __attribute__((aligned(16))) char shm[];
    cg::grid_group grid = cg::this_grid();
    volatile LAS unsigned* st = (volatile LAS unsigned*)(shm + LDS_ITEM_OFF + 16);
    if (threadIdx.x < 2) st[threadIdx.x] = 0u;
    __syncthreads();
    XcdBarrier bar;
    { const Params q = load_params(); bar = xcd_barrier_post(q.bar, st); }
#define STAGE(S, l) { const Params q = load_params(); run_stage<S>(q, l, shm); }
#if PROBE == 11
#define SYNC() xcd_barrier(bar); xcd_barrier(bar);
#else
#define SYNC() xcd_barrier(bar);
#endif
    { const Params q = load_params(); if (q.bar == nullptr) grid.sync(); }
    STAGE(8, 0)
    if (PROBE == 1) { SYNC() STAGE(8, 0) }
    SYNC()
    STAGE(0, 0)
#define DUP(n, S, l) if (PROBE == n) { SYNC() STAGE(S, l) }
#define LAYER_REST(l) DUP(2, 0, l) SYNC() STAGE(1, l) if (PROBE >= 3 && PROBE <= 5) { SYNC() STAGE(9, l) } if (PROBE == 12) { SYNC() STAGE(12, l) } SYNC() STAGE(2, l) SYNC() STAGE(10, l) if (PROBE == 8) { SYNC() STAGE(2, l) SYNC() STAGE(10, l) } \
    SYNC() STAGE(3, l) DUP(9, 3, l) SYNC() STAGE(14, l) SYNC() STAGE(4, l) SYNC() STAGE(5, l) DUP(6, 5, l) SYNC() STAGE(6, l) DUP(7, 6, l) SYNC() STAGE(7, l)
    LAYER_REST(0)
    SYNC() STAGE(0, 1)
    LAYER_REST(1)
#undef LAYER_REST
#undef SYNC
#undef STAGE
}
#else
template <int S>
__global__ void __launch_bounds__(512, 2) k_one(Params p, int l) {
    extern __shared__ __attribute__((aligned(16))) char shm[];
    run_stage<S>(p, l, shm);
}
template <int S> static void launch_one(const Params& p, int l, hipStream_t stream) {
    (void)hipFuncSetAttribute((const void*)k_one<S>, hipFuncAttributeMaxDynamicSharedMemorySize, LDS_BYTES);
    hipLaunchKernelGGL(k_one<S>, dim3(256), dim3(512), LDS_BYTES, stream, p, l);
}
#endif

extern "C" void kernel_launch(void* const* d_in, const int* in_sizes, int n_in, void* d_out, int out_size, void* d_ws, size_t ws_size, hipStream_t stream) {
    Params p{};
    const float* const* in = (const float* const*)d_in;
    p.x_prompt = in[0]; p.x_sample = in[1]; p.cache_k = in[2]; p.cache_v = in[3]; p.cache_logf = in[4]; p.state_gla = in[5]; p.g_mix_pre = in[6]; p.w_in = in[7];
    p.w_gate_up = in[8]; p.b_gate = in[9]; p.b_fox_f = in[10]; p.g_onorm = in[11]; p.w_out = in[12]; p.g_mix_post = in[13]; p.g_mlp_pre = in[14]; p.w_up = in[15];
    p.w_down = in[16]; p.g_mlp_post = in[17];
    p.out = (float*)d_out;
    char* w = (char*)d_ws; size_t off = 0;
    auto take = [&](size_t bytes) { char* r = w + off; off += (bytes + 255) & ~(size_t)255; return r; };
    p.ctr = (unsigned*)take(256);
    p.bar = (unsigned*)take((size_t)XCD_BAR_WORDS * 4);
    p.WinT = (bf16_t*)take((size_t)2 * NIN * DM * 2); p.WoutT = (bf16_t*)take((size_t)2 * DM * DM * 2);
    p.WupT = (bf16_t*)take((size_t)2 * DFF * DM * 2); p.WdownT = (bf16_t*)take((size_t)2 * DM * DFF * 2);
    p.H = (bf16_t*)take((size_t)MT * DM * 2); p.MRG = (bf16_t*)take((size_t)MT * DM * 2); p.Z = (bf16_t*)take((size_t)MT * NZ * 2);
    p.U = (bf16_t*)take((size_t)MT * DFF * 2);
    p.EX = (float*)take((size_t)MT * 32 * 4); p.RAW = (bf16_t*)take((size_t)MT * DM * 2); p.YB = (bf16_t*)take((size_t)MT * DM * 2); p.OG = (float*)take((size_t)MT * 1024 * 4); p.DEC = (float*)take((size_t)544 * 128 * 4); p.PART = (float*)take((size_t)SPLIT_DOWN * 256 * DM * 4);
    p.FSO = (float*)take((size_t)256 * 32 * 128 * 4); p.FSML = (float*)take((size_t)256 * 32 * 2 * 4);
    p.KVT = (float*)p.U; p.SS = (bf16_t*)((char*)p.U + (size_t)544 * 32768 * 4); p.QI = (bf16_t*)((char*)p.U + (size_t)544 * 32768 * 6);
    if (off > ws_size) { fprintf(stderr, "workspace too small: need %zu have %zu\n", off, ws_size); return; }
#if MEGA
    static int grid_blocks = 0;
    if (!grid_blocks) {
        (void)hipFuncSetAttribute((const void*)k_mega, hipFuncAttributeMaxDynamicSharedMemorySize, LDS_BYTES);
        int dev = 0, cus = 0, per_cu = 0; hipGetDevice(&dev); hipDeviceGetAttribute(&cus, hipDeviceAttributeMultiprocessorCount, dev);
        hipOccupancyMaxActiveBlocksPerMultiprocessor(&per_cu, k_mega, 512, LDS_BYTES);
        if (per_cu < 1) per_cu = 1;
        grid_blocks = cus;
    }
    (void)hipMemsetAsync(p.bar, 0, (size_t)XCD_BAR_WORDS * 4, stream);
    void* args[] = {&p};
    hipError_t e = hipLaunchCooperativeKernel((void*)k_mega, dim3(grid_blocks), dim3(512), args, LDS_BYTES, stream);
    if (e != hipSuccess) fprintf(stderr, "cooperative launch failed: %s (grid %d)\n", hipGetErrorString(e), grid_blocks);
#else
    launch_one<8>(p, 0, stream);
    for (int l = 0; l < 2; ++l) { launch_one<0>(p, l, stream); launch_one<1>(p, l, stream); launch_one<2>(p, l, stream); launch_one<10>(p, l, stream); launch_one<3>(p, l, stream);
        launch_one<14>(p, l, stream); launch_one<4>(p, l, stream); launch_one<5>(p, l, stream); launch_one<6>(p, l, stream); launch_one<7>(p, l, stream); }
#endif
}
```

```cpp
#include <hip/hip_runtime.h>
#include <hip/hip_cooperative_groups.h>
#include <cstdio>
namespace cg = cooperative_groups;
#ifndef MEGA
#define MEGA 1
#endif
#ifndef PROBE
#define PROBE 0
#endif
__device__ __forceinline__ int tid_opaque() { int t = threadIdx.x; asm volatile("" : "+v"(t)); return t; }
#define XB_TMO      128
#define XB_XCNT(j)  (256  + 64 * (j))
#define XB_XSUB(j)  (1280 + 64 * (j))
#define XB_XGEN(j)  (2304 + 64 * (j))
#define XB_TOP      3328
#define XB_TOPGEN   3392
#define XCD_BAR_WORDS 3456
#define XB_SPIN_CAP (1u << 18)
#define LAS __attribute__((address_space(3)))

__device__ __forceinline__ unsigned xb_ld(unsigned* p)              { return __hip_atomic_load(p, __ATOMIC_RELAXED, __HIP_MEMORY_SCOPE_AGENT); }
__device__ __forceinline__ unsigned xb_add(unsigned* p, unsigned v) { return __hip_atomic_fetch_add(p, v, __ATOMIC_RELAXED, __HIP_MEMORY_SCOPE_AGENT); }
__device__ __forceinline__ unsigned xb_xcc_id() { return (unsigned)__builtin_amdgcn_s_getreg((3 << 11) | 20) & 0xFu; }
#define XB_SPIN(cond, bar) do { unsigned _sp = 0; while (cond) { __builtin_amdgcn_s_sleep(1); \
    if ((++_sp & 255u) == 0u) { if (xb_ld(&(bar)[XB_TMO])) break; if (_sp > XB_SPIN_CAP) { atomicAdd(&(bar)[XB_TMO], 1u); break; } } } } while (0)

struct XcdBarrier {
    unsigned* bar; unsigned x;
    volatile LAS unsigned* st;
};

__device__ __forceinline__ XcdBarrier xcd_barrier_post(unsigned* bar, volatile LAS unsigned* st) {
    XcdBarrier b; b.bar = bar; b.x = xb_xcc_id(); b.st = st;
    if (threadIdx.x == 0) (void)xb_add(&bar[XB_XCNT(b.x)], 1u);
    return b;
}
__device__ __forceinline__ void xcd_barrier_complete(unsigned* bar, unsigned x, unsigned& nloc, unsigned& nx) {
    const unsigned G = gridDim.x * gridDim.y * gridDim.z;
    unsigned sum, cnt, mine, sp = 0u;
    for (;;) {
        sum = 0u; cnt = 0u; mine = 0u;
#pragma unroll
        for (unsigned j = 0; j < 16; ++j) { const unsigned c = xb_ld(&bar[XB_XCNT(j)]); sum += c; cnt += (c > 0u) ? 1u : 0u; mine = (j == x) ? c : mine; }
        if (sum == G) break;
        __builtin_amdgcn_s_sleep(1);
        if ((++sp & 255u) == 0u) { if (xb_ld(&bar[XB_TMO])) break; if (sp > XB_SPIN_CAP) { atomicAdd(&bar[XB_TMO], 1u); break; } }
    }
    nloc = mine > 0u ? mine : 1u; nx = cnt > 0u ? cnt : 1u;
}

__device__ __forceinline__ void xcd_barrier(const XcdBarrier& b) {
    asm volatile("s_waitcnt vmcnt(0)" ::: "memory");
    __syncthreads();
    if (threadIdx.x == 0) {
        unsigned* bar = b.bar;
        __builtin_amdgcn_s_waitcnt(0);
        unsigned nloc = b.st[0], nx = b.st[1];
        if (nloc == 0u) { xcd_barrier_complete(bar, b.x, nloc, nx); b.st[0] = nloc; b.st[1] = nx; }
        const unsigned old = xb_add(&bar[XB_XSUB(b.x)], 1u);
        const unsigned gen = old / nloc;
        if (old + 1u == (gen + 1u) * nloc) {
            __builtin_amdgcn_fence(__ATOMIC_RELEASE, "agent");
            asm volatile("s_waitcnt vmcnt(0)" ::: "memory");
            const unsigned og = xb_add(&bar[XB_TOP], 1u);
            const unsigned tg = og / nx;
            if (og + 1u == (tg + 1u) * nx) xb_add(&bar[XB_TOPGEN], 1u);
            else XB_SPIN(xb_ld(&bar[XB_TOPGEN]) == tg, bar);
            __builtin_amdgcn_fence(__ATOMIC_ACQUIRE, "agent");
            xb_add(&bar[XB_XGEN(b.x)], 1u);
            asm volatile("s_waitcnt vmcnt(0)" ::: "memory");
        } else {
            XB_SPIN(xb_ld(&bar[XB_XGEN(b.x)]) == gen, bar);
            __builtin_amdgcn_fence(__ATOMIC_ACQUIRE, "agent");
            asm volatile("s_waitcnt vmcnt(0)" ::: "memory");
        }
    }
    __syncthreads();
}
namespace pg8 {
#define PG8_LAS __attribute__((address_space(3)))
typedef unsigned short bf16_t;
typedef short bf16x8 __attribute__((ext_vector_type(8)));
typedef float f32x4 __attribute__((ext_vector_type(4)));
typedef unsigned u32x4 __attribute__((ext_vector_type(4)));
constexpr int BM = 256, BK = 64, HALF = 128, HTB = HALF * BK * 2  , STAGE_BYTES = 8 * HTB, NXCD = 8, WGM = 8;

__host__ __device__ __forceinline__ int lds_byte(int r, int c) { const int st = (r >> 4) * 2 + (c >> 5), rr = r & 15, cc = c & 31, ob = rr * 64 + cc * 2; return st * 1024 + (ob ^ (((ob >> 9) & 1) << 5)); }
__host__ __device__ __forceinline__ void stage_rc(int b, int& R, int& C) { const int st = b / 1024, sb = b % 1024, swz = sb ^ (((sb >> 9) & 1) << 5); R = (st >> 1) * 16 + swz / 64; C = (st & 1) * 32 + (swz % 64) / 2; }
__host__ __device__ __forceinline__ int perm32(int rho) { const int n = rho >> 4, i = rho & 15; return 8 * (i >> 2) + 4 * n + (i & 3); }

struct Unit { int pm, pn; };
struct Gemm { const bf16_t* A; const bf16_t* Bt; int M, N, K; int lda, ldb, nct, ksub; };

struct StaticOrder {
    int nM, nN, nwg, G, c;
    __host__ __device__ void init(int M, int N, int G_, int c_) { nM = M / BM; nN = N / BM; nwg = nM * nN; G = G_; c = c_; }
    __host__ __device__ bool next(int i, Unit& u) const {
        const long L = (long)i * G + c; if (L >= nwg) return false;
        int wgid = (int)L; { const int q = nwg / NXCD, r = nwg % NXCD, xcd = wgid % NXCD, off = wgid / NXCD; wgid = (xcd < r ? xcd * (q + 1) : r * (q + 1) + (xcd - r) * q) + off; }
        const int nig = WGM * nN, gid = wgid / nig, fm = gid * WGM, gsz = (nM - fm) < WGM ? (nM - fm) : WGM;
        u.pm = fm + ((wgid % nig) % gsz); u.pn = (wgid % nig) / gsz; return true;
    }
    __device__ __forceinline__ void a_ready(const Unit&) const {}
    __device__ __forceinline__ void done(const Unit&) const {}
};

template <class Epi, class Sched, bool STAMP = false>
__device__ __forceinline__ void gemm_phase(PG8_LAS unsigned char* lds, const Gemm g, const Sched& S, const Epi& E, unsigned long long* stamps) {
    const int tid = tid_opaque(), wid = __builtin_amdgcn_readfirstlane(tid >> 6), lane = tid & 63, wr = wid >> 2, wc = wid & 3, fr = lane & 15, fq = lane >> 4;
    const int K = g.K, nt = K / BK;
    int ts_lo = 0, ts_hi = 0, nts = 0; const unsigned long long rt_entry = STAMP ? (unsigned long long)wall_clock64() : 0ull;
#define PG8_STAMP() do { if (STAMP && wid == 0 && nts < 64) { const unsigned long long _c = (unsigned long long)clock64(); \
        ts_lo = (lane == nts) ? (int)(unsigned)_c : ts_lo; ts_hi = (lane == nts) ? (int)(unsigned)(_c >> 32) : ts_hi; ++nts; } } while (0)
    PG8_STAMP();
    unsigned voffA[2], voffB[2];
#pragma unroll
    for (int i = 0; i < 2; ++i) { int R, C; stage_rc(tid * 16 + i * 8192, R, C); const int Rb = Epi::PERM ? ((R & ~31) + perm32(R & 31)) : R;
        voffA[i] = (unsigned)(R * g.lda + C) * 2u; voffB[i] = (unsigned)(Rb * g.ldb + C) * 2u; }
    const size_t kstep = (size_t)(BK * 2);
    const size_t hstepA = (size_t)HALF * g.lda * 2, hstepB = (size_t)HALF * g.ldb * 2;
    const size_t tstepA = 2 * hstepA, tstepB = 2 * hstepB;
    const unsigned ldsw = (unsigned)wid * 1024u;
    const int aoff = lds_byte(wr * 64 + fr, fq * 8), boff = lds_byte(wc * 32 + fr, fq * 8);
#define PG8_SA(b, h) (((b) * 2 + (h)) * HTB)
#define PG8_SB(b, h) ((4 + (b) * 2 + (h)) * HTB)
#define PG8_STAGE(bufoff, gbase, voff) do { _Pragma("unroll") for (int _i = 0; _i < 2; ++_i) \
        __builtin_amdgcn_global_load_lds((const unsigned*)((const char*)(gbase) + (voff)[_i]), (PG8_LAS unsigned*)(lds + (bufoff) + ldsw + _i * 8192), 16, 0, 0); } while (0)
#define PG8_LDA(dst, b, h) do { _Pragma("unroll") for (int m = 0; m < 4; ++m) _Pragma("unroll") for (int k = 0; k < 2; ++k) dst[m][k] = *(const PG8_LAS bf16x8*)(lds + PG8_SA(b, h) + aoff + m * 2048 + k * 1024); } while (0)
#define PG8_LDB(dst, b, h) do { _Pragma("unroll") for (int n = 0; n < 2; ++n) _Pragma("unroll") for (int k = 0; k < 2; ++k) dst[n][k] = *(const PG8_LAS bf16x8*)(lds + PG8_SB(b, h) + boff + n * 2048 + k * 1024); } while (0)
#define PG8_MMA(ai, bj, At, Bt) do { __builtin_amdgcn_s_setprio(1); _Pragma("unroll") for (int m = 0; m < 4; ++m) _Pragma("unroll") for (int n = 0; n < 2; ++n) _Pragma("unroll") for (int k = 0; k < 2; ++k) \
        acc[ai][bj][m][n] = __builtin_amdgcn_mfma_f32_16x16x32_bf16(Bt[n][k], At[m][k], acc[ai][bj][m][n], 0, 0, 0); __builtin_amdgcn_s_setprio(0); } while (0)
#define PG8_WAIT_V(n) asm volatile("s_waitcnt vmcnt(" #n ")" ::: "memory")
#define PG8_WAIT_L(n) asm volatile("s_waitcnt lgkmcnt(" #n ")" ::: "memory")
#define PG8_BAR __builtin_amdgcn_s_barrier()
#define PG8_SCHED __builtin_amdgcn_sched_barrier(0)
    Unit cur, nxt; int ui = 0;
    if (!S.next(0, cur)) return;
    f32x4 acc[2][2][4][2];
#pragma unroll
    for (int a = 0; a < 2; ++a)
#pragma unroll
        for (int b = 0; b < 2; ++b)
#pragma unroll
            for (int m = 0; m < 4; ++m)
#pragma unroll
                for (int n = 0; n < 2; ++n) acc[a][b][m][n] = (f32x4){0.f, 0.f, 0.f, 0.f};
    bf16x8 At[4][2], B0[2][2], B1[2][2];
    const char* cA = (const char*)g.A + (size_t)cur.pm * tstepA + (size_t)(cur.pn / g.nct) * g.ksub * 2; const char* cB = (const char*)g.Bt + (size_t)(cur.pn % g.nct) * tstepB + (size_t)(cur.pn / g.nct) * g.ksub * 2;
    S.a_ready(cur);
    PG8_STAGE(PG8_SB(0, 0), cB, voffB); PG8_STAGE(PG8_SA(0, 0), cA, voffA); PG8_STAGE(PG8_SB(0, 1), cB + hstepB, voffB); PG8_STAGE(PG8_SA(0, 1), cA + hstepA, voffA);
    if (wr == 1) PG8_BAR;
    PG8_WAIT_V(4); PG8_BAR;
    PG8_STAGE(PG8_SB(1, 0), cB + kstep, voffB); PG8_STAGE(PG8_SA(1, 0), cA + kstep, voffA); PG8_STAGE(PG8_SB(1, 1), cB + hstepB + kstep, voffB);
    PG8_WAIT_V(6); PG8_BAR;
    PG8_STAMP();
    for (;;) {
        const bool has_next = S.next(ui + 1, nxt);
        const char* nA = has_next ? (const char*)g.A + (size_t)nxt.pm * tstepA + (size_t)(nxt.pn / g.nct) * g.ksub * 2 : cA; const char* nB = has_next ? (const char*)g.Bt + (size_t)(nxt.pn % g.nct) * tstepB + (size_t)(nxt.pn / g.nct) * g.ksub * 2 : cB;
        for (int t = 0; t < nt; t += 2) {
            const bool last = (t == nt - 2);
            const char* a1 = cA + (size_t)(t + 1) * kstep;
            const char* a2 = last ? nA : cA + (size_t)(t + 2) * kstep; const char* b2 = last ? nB : cB + (size_t)(t + 2) * kstep;
            const char* a3 = a2 + kstep; const char* b3 = b2 + kstep;
            if (last && has_next) S.a_ready(nxt);
            PG8_LDB(B0, 0, 0); PG8_SCHED; PG8_LDA(At, 0, 0); PG8_STAGE(PG8_SA(1, 1), a1 + hstepA, voffA);
            PG8_WAIT_L(8); PG8_BAR; PG8_WAIT_L(0); PG8_MMA(0, 0, At, B0); PG8_BAR; PG8_SCHED;
            PG8_LDB(B1, 0, 1); PG8_STAGE(PG8_SB(0, 0), b2, voffB);
            PG8_BAR; PG8_WAIT_L(0); PG8_MMA(0, 1, At, B1); PG8_BAR;
            PG8_LDA(At, 0, 1); PG8_STAGE(PG8_SA(0, 0), a2, voffA);
            PG8_BAR; PG8_WAIT_L(0); PG8_MMA(1, 0, At, B0); PG8_BAR; PG8_SCHED;
            PG8_STAGE(PG8_SB(0, 1), b2 + hstepB, voffB);
            PG8_WAIT_V(6); PG8_BAR; PG8_MMA(1, 1, At, B1); PG8_BAR;
            PG8_LDB(B0, 1, 0); PG8_SCHED; PG8_LDA(At, 1, 0); PG8_STAGE(PG8_SA(0, 1), a2 + hstepA, voffA);
            PG8_WAIT_L(8); PG8_BAR; PG8_WAIT_L(0); PG8_MMA(0, 0, At, B0); PG8_BAR; PG8_SCHED;
            PG8_LDB(B1, 1, 1); PG8_STAGE(PG8_SB(1, 0), b3, voffB);
            PG8_BAR; PG8_WAIT_L(0); PG8_MMA(0, 1, At, B1); PG8_BAR;
            PG8_LDA(At, 1, 1); PG8_STAGE(PG8_SA(1, 0), a3, voffA);
            PG8_BAR; PG8_WAIT_L(0); PG8_MMA(1, 0, At, B0); PG8_BAR; PG8_SCHED;
            PG8_STAGE(PG8_SB(1, 1), b3 + hstepB, voffB);
            PG8_WAIT_V(6); PG8_BAR; PG8_MMA(1, 1, At, B1); PG8_BAR;
        }
        PG8_STAMP();
        if constexpr (!Epi::AFTER_DRAIN) { E(acc, cur, wr, wc, fr, fq); S.done(cur); }
        PG8_STAMP();
        if (!has_next) break;
#pragma unroll
        for (int a = 0; a < 2; ++a)
#pragma unroll
            for (int b = 0; b < 2; ++b)
#pragma unroll
                for (int m = 0; m < 4; ++m)
#pragma unroll
                    for (int n = 0; n < 2; ++n) acc[a][b][m][n] = (f32x4){0.f, 0.f, 0.f, 0.f};
        cur = nxt; cA = nA; cB = nB; ++ui;
    }
    PG8_WAIT_V(0);
    if (wr == 0) PG8_BAR;
    PG8_BAR;
    if constexpr (Epi::AFTER_DRAIN) { E.fused(acc, cur, wr, wc, fr, fq, lds, wid, lane); S.done(cur); }
    PG8_STAMP();
    if (STAMP && wid == 0) { stamps[lane] = lane < nts ? (((unsigned long long)(unsigned)ts_hi << 32) | (unsigned)ts_lo) : 0ull;
        if (lane == 62) stamps[62] = rt_entry; if (lane == 63) stamps[63] = (unsigned long long)wall_clock64(); }
#undef PG8_STAMP
#undef PG8_SA
#undef PG8_SB
#undef PG8_STAGE
#undef PG8_LDA
#undef PG8_LDB
#undef PG8_MMA
#undef PG8_WAIT_V
#undef PG8_WAIT_L
#undef PG8_BAR
#undef PG8_SCHED
}
}

using pg8::bf16_t; using pg8::bf16x8; using pg8::f32x4; using pg8::u32x4;
typedef short s16x4 __attribute__((ext_vector_type(4)));
typedef float f32x16 __attribute__((ext_vector_type(16)));
typedef unsigned u32x2 __attribute__((ext_vector_type(2)));
#define DI __device__ __forceinline__
#define MFMA32(a, b, c) __builtin_amdgcn_mfma_f32_32x32x16_bf16((a), (b), (c), 0, 0, 0)

constexpr int NP = 8192, NS = 256, MT = 8448, DM = 2048, NZ = 6144, NIN = 6400, DFF = 8192;
constexpr float EPS = 1e-6f, LOG2E = 1.4426950408889634f;
constexpr int LDS_BYTES = 154112;
constexpr int LDS_ITEM_OFF = 153792;
constexpr size_t O_YP = 0, O_YS = 16777216, O_KP = 17301504, O_VP = 34078720, O_LFP = 50855936, O_STP = 50987008,
                 O_KS = 52035584, O_VS = 52559872, O_LFS = 53084160, O_STS = 53088256;

struct Params {
    const float *x_prompt, *x_sample, *cache_k, *cache_v, *cache_logf, *state_gla, *g_mix_pre, *w_in, *w_gate_up, *b_gate, *b_fox_f,
                *g_onorm, *w_out, *g_mix_post, *g_mlp_pre, *w_up, *w_down, *g_mlp_post;
    float* out;
    bf16_t *WinT, *WoutT, *WupT, *WdownT, *H, *MRG, *Z, *U;
    bf16_t* RAW;
    bf16_t* YB;
    float *EX, *OG, *DEC, *KVT, *PART, *FSO, *FSML;
    bf16_t *SS, *QI;
    unsigned* ctr;
    unsigned* bar;
};

DI unsigned pk2(float a, float b) { typedef __bf16 v2 __attribute__((ext_vector_type(2))); v2 v; v[0] = (__bf16)a; v[1] = (__bf16)b; return __builtin_bit_cast(unsigned, v); }
DI bf16_t f2bf(float a) { return __builtin_bit_cast(unsigned short, (__bf16)a); }
DI float bf2f(unsigned u) { return __uint_as_float(u << 16); }
DI float bflo(unsigned u) { return __uint_as_float(u << 16); }
DI float bfhi(unsigned u) { return __uint_as_float(u & 0xffff0000u); }
DI float logsig(float x) { return fminf(x, 0.f) - log1pf(__expf(-fabsf(x))); }
DI int crow(int reg, int h) { return (reg & 3) + 8 * (reg >> 2) + 4 * h; }
DI float wave_sum(float v) {
#pragma unroll
    for (int o = 32; o >= 1; o >>= 1) v += __shfl_xor(v, o);
    return v;
}

struct EpiIn {
    static constexpr bool PERM = true, AFTER_DRAIN = false;
    bf16_t* Z; float* EX; float *outk_p, *outv_p, *outk_s, *outv_s; int row_base, pn_base;
    DI void operator()(const f32x4 (&acc)[2][2][4][2], const pg8::Unit& u, int wr, int wc, int fr, int fq) const {
        const int row0 = row_base + u.pm * 256 + wr * 64 + fr, pn = pn_base + u.pn;
        const float sc = pn < 2 ? 0.08838834764831845f : 1.0f;
#pragma unroll
        for (int ai = 0; ai < 2; ++ai)
#pragma unroll
            for (int m = 0; m < 4; ++m) {
                const int row = row0 + ai * 128 + m * 16;
#pragma unroll
                for (int bj = 0; bj < 2; ++bj) {
                    const int cc = bj * 128 + wc * 32 + 8 * fq;
                    const f32x4 v0 = acc[ai][bj][m][0], v1 = acc[ai][bj][m][1];
                    if (pn < 24) {
                        u32x4 pk; pk[0] = pk2(v0[0] * sc, v0[1] * sc); pk[1] = pk2(v0[2] * sc, v0[3] * sc); pk[2] = pk2(v1[0] * sc, v1[1] * sc); pk[3] = pk2(v1[2] * sc, v1[3] * sc);
                        *(u32x4*)(Z + (size_t)row * NZ + pn * 256 + cc) = pk;
                        if (pn >= 16) {
                            const bool isk = pn < 20; const int gc = (pn - (isk ? 16 : 20)) * 256 + cc;
                            float* dst = row < NP ? (isk ? outk_p : outv_p) + (size_t)row * 1024 + gc : (isk ? outk_s : outv_s) + (size_t)(row - NP) * 1024 + gc;
                            *(f32x4*)dst = v0; *(f32x4*)(dst + 4) = v1;
                        }
                    } else if (cc < 24) {
                        float* ex = EX + (size_t)row * 32 + cc;
                        *(f32x4*)ex = v0; *(f32x4*)(ex + 4) = v1;
                    }
                }
            }
    }
};
struct EpiRaw {
    static constexpr bool PERM = true, AFTER_DRAIN = false;
    bf16_t* C;
    DI void operator()(const f32x4 (&acc)[2][2][4][2], const pg8::Unit& u, int wr, int wc, int fr, int fq) const {
        const int row0 = u.pm * 256 + wr * 64 + fr, col0 = u.pn * 256 + wc * 32 + 8 * fq;
#pragma unroll
        for (int ai = 0; ai < 2; ++ai)
#pragma unroll
            for (int m = 0; m < 4; ++m) {
                bf16_t* rp = C + (size_t)(row0 + ai * 128 + m * 16) * DM + col0;
#pragma unroll
                for (int bj = 0; bj < 2; ++bj) {
                    const f32x4 a = acc[ai][bj][m][0], b = acc[ai][bj][m][1];
                    u32x4 pk; pk[0] = pk2(a[0], a[1]); pk[1] = pk2(a[2], a[3]); pk[2] = pk2(b[0], b[1]); pk[3] = pk2(b[2], b[3]);
                    *(u32x4*)(rp + bj * 128) = pk;
                }
            }
    }
};
struct EpiUp {
    static constexpr bool PERM = true, AFTER_DRAIN = false;
    bf16_t* U;
    DI void operator()(const f32x4 (&acc)[2][2][4][2], const pg8::Unit& u, int wr, int wc, int fr, int fq) const {
        const int row0 = u.pm * 256 + wr * 64 + fr, col0 = u.pn * 256 + wc * 32 + 8 * fq;
#pragma unroll
        for (int ai = 0; ai < 2; ++ai)
#pragma unroll
            for (int m = 0; m < 4; ++m) {
                bf16_t* rp = U + (size_t)(row0 + ai * 128 + m * 16) * DFF + col0;
#pragma unroll
                for (int bj = 0; bj < 2; ++bj) {
                    f32x4 a = acc[ai][bj][m][0], b = acc[ai][bj][m][1];
#pragma unroll
                    for (int e = 0; e < 4; ++e) { a[e] = fmaxf(a[e], 0.f); a[e] *= a[e]; b[e] = fmaxf(b[e], 0.f); b[e] *= b[e]; }
                    u32x4 pk; pk[0] = pk2(a[0], a[1]); pk[1] = pk2(a[2], a[3]); pk[2] = pk2(b[0], b[1]); pk[3] = pk2(b[2], b[3]);
                    *(u32x4*)(rp + bj * 128) = pk;
                }
            }
    }
};

struct EpiPart {
    static constexpr bool PERM = true, AFTER_DRAIN = false;
    bf16_t* P;
    DI void operator()(const f32x4 (&acc)[2][2][4][2], const pg8::Unit& u, int wr, int wc, int fr, int fq) const {
        const int split = u.pn >> 3, ct = u.pn & 7;
        const int row0 = wr * 64 + fr, col0 = ct * 256 + wc * 32 + 8 * fq;
#pragma unroll
        for (int ai = 0; ai < 2; ++ai)
#pragma unroll
            for (int m = 0; m < 4; ++m) {
                bf16_t* rp = P + ((size_t)split * 256 + row0 + ai * 128 + m * 16) * DM + col0;
#pragma unroll
                for (int bj = 0; bj < 2; ++bj) { const f32x4 a = acc[ai][bj][m][0], b = acc[ai][bj][m][1];
                    u32x4 pk; pk[0] = pk2(a[0], a[1]); pk[1] = pk2(a[2], a[3]); pk[2] = pk2(b[0], b[1]); pk[3] = pk2(b[2], b[3]); *(u32x4*)(rp + bj * 128) = pk; }
            }
    }
};

template <class Epi>
DI void run_gemm(char* shm, const bf16_t* A, const bf16_t* Bt, int M, int N, int K, int lda, int ldb, int nsplit, const Epi& E, int G = 0, int c = 0) {
    pg8::Gemm g; g.A = A; g.Bt = Bt; g.M = M; g.N = N * nsplit; g.K = K; g.lda = lda; g.ldb = ldb; g.nct = N / 256; g.ksub = K;
    if (G == 0) { G = (int)gridDim.x; c = (int)blockIdx.x; }
    pg8::StaticOrder S; S.init(M, N * nsplit, G, c);
    pg8::gemm_phase<Epi, pg8::StaticOrder, false>((PG8_LAS unsigned char*)shm, g, S, E, nullptr);
}

DI void norm_rows(const float* xin_p, const float* xin_s, const bf16_t* raw, const float* part, int nsplit, const float* gpost, const float* gnext, float* yout_p, float* yout_s, bf16_t* H,
                  int row_lo, int row_hi, int wblk, int nwblk, bool spread = false, const bf16_t* xb = nullptr, bf16_t* yb = nullptr) {
    const int lane = tid_opaque() & 63, wid = tid_opaque() >> 6;
    for (int row = row_lo + (spread ? wblk + wid * nwblk : wblk * 8 + wid); row < row_hi; row += nwblk * 8) {
        f32x4 xv[8];
        if (xb) {
#pragma unroll
            for (int i = 0; i < 8; ++i) { const u32x2 b = *(const u32x2*)(xb + (size_t)row * DM + (i * 64 + lane) * 4); xv[i][0] = bflo(b[0]); xv[i][1] = bfhi(b[0]); xv[i][2] = bflo(b[1]); xv[i][3] = bfhi(b[1]); }
        } else {
            const float* xi = row < NP ? xin_p + (size_t)row * DM : xin_s + (size_t)(row - NP) * DM;
#pragma unroll
            for (int i = 0; i < 8; ++i) xv[i] = *(const f32x4*)(xi + (i * 64 + lane) * 4);
        }
        if (raw) {
            f32x4 rv[8]; float ss = 0.f;
            if (row < NP) {
#pragma unroll
                for (int i = 0; i < 8; ++i) { const u32x2 rb = *(const u32x2*)(raw + (size_t)row * DM + (i * 64 + lane) * 4); rv[i][0] = bflo(rb[0]); rv[i][1] = bfhi(rb[0]); rv[i][2] = bflo(rb[1]); rv[i][3] = bfhi(rb[1]); }
            } else {
                const bf16_t* pr = (const bf16_t*)part + (size_t)(row - NP) * DM + lane * 4;
#pragma unroll
                for (int i = 0; i < 8; ++i) { const u32x2 b = *(const u32x2*)(pr + i * 256); rv[i][0] = bflo(b[0]); rv[i][1] = bfhi(b[0]); rv[i][2] = bflo(b[1]); rv[i][3] = bfhi(b[1]); }
#pragma unroll 4
                for (int s = 1; s < nsplit; ++s) {
                    u32x2 tv[8];
#pragma unroll
                    for (int i = 0; i < 8; ++i) tv[i] = *(const u32x2*)(pr + (size_t)s * 256 * DM + i * 256);
#pragma unroll
                    for (int i = 0; i < 8; ++i) { rv[i][0] += bflo(tv[i][0]); rv[i][1] += bfhi(tv[i][0]); rv[i][2] += bflo(tv[i][1]); rv[i][3] += bfhi(tv[i][1]); }
                }
            }
#pragma unroll
            for (int i = 0; i < 8; ++i) ss += rv[i][0] * rv[i][0] + rv[i][1] * rv[i][1] + rv[i][2] * rv[i][2] + rv[i][3] * rv[i][3];
            ss = wave_sum(ss); const float rs = rsqrtf(ss * (1.0f / DM) + EPS);
#pragma unroll
            for (int i = 0; i < 8; ++i) { const f32x4 gp = *(const f32x4*)(gpost + (i * 64 + lane) * 4); xv[i] += rv[i] * rs * gp; }
            if (yb) {
#pragma unroll
                for (int i = 0; i < 8; ++i) { u32x2 pk; pk[0] = pk2(xv[i][0], xv[i][1]); pk[1] = pk2(xv[i][2], xv[i][3]); *(u32x2*)(yb + (size_t)row * DM + (i * 64 + lane) * 4) = pk; }
            } else {
                float* yo = row < NP ? yout_p + (size_t)row * DM : yout_s + (size_t)(row - NP) * DM;
#pragma unroll
                for (int i = 0; i < 8; ++i) *(f32x4*)(yo + (i * 64 + lane) * 4) = xv[i];
            }
        }
        if (gnext) {
            float ss = 0.f;
#pragma unroll
            for (int i = 0; i < 8; ++i) ss += xv[i][0] * xv[i][0] + xv[i][1] * xv[i][1] + xv[i][2] * xv[i][2] + xv[i][3] * xv[i][3];
            ss = wave_sum(ss); const float rs = rsqrtf(ss * (1.0f / DM) + EPS);
#pragma unroll
            for (int i = 0; i < 8; ++i) {
                const f32x4 gn = *(const f32x4*)(gnext + (i * 64 + lane) * 4); const f32x4 hv = xv[i] * rs * gn;
                u32x2 pk; pk[0] = pk2(hv[0], hv[1]); pk[1] = pk2(hv[2], hv[3]);
                *(u32x2*)(H + (size_t)row * DM + (i * 64 + lane) * 4) = pk;
            }
        }
    }
}

constexpr int RG_IN = 18;
struct InOrder {
    pg8::StaticOrder so; int G, c;
    DI void init(int G_, int c_) { so.init(MT, 21 * 256, G_, c_); G = G_; c = c_; }
    DI bool next(int i, pg8::Unit& u) const {
        const int L = i * G + c;
        if (L < 693) { so.next(i, u); if (u.pn >= 8) u.pn += 4; return true; }
        const int L2 = L - 693;
        if (L2 < RG_IN * 4) { u.pm = L2 >> 2; u.pn = 8 + (L2 & 3); return true; }
        return false;
    }
    DI void a_ready(const pg8::Unit&) const {}
    DI void done(const pg8::Unit&) const {}
};

struct ConvTile { const float* src; bf16_t* dst; int ld, Kd, k0, n0, sc; };
DI ConvTile conv_tile(const Params& p, int t, int lane) {
    ConvTile c; const int l = t >= 3104 ? 1 : 0; int u = t - l * 3104; int nn;
    if (u < 800) { c.k0 = (u / 25) * 64; c.n0 = (u % 25) * 256; c.src = p.w_in + (size_t)l * DM * 6168; c.ld = 6168; c.dst = p.WinT + (size_t)l * NIN * DM; c.Kd = DM; nn = c.n0 + 4 * lane;
        c.sc = nn < 2048 ? nn : nn < 6144 ? nn + 16 : nn < 6160 ? nn - 4096 : nn < 6168 ? nn : -1; }
    else if ((u -= 800) < 256) { c.k0 = (u >> 3) * 64; c.n0 = (u & 7) * 256; c.src = p.w_out + (size_t)l * DM * DM; c.ld = DM; c.dst = p.WoutT + (size_t)l * DM * DM; c.Kd = DM; c.sc = c.n0 + 4 * lane; }
    else if ((u -= 256) < 1024) { c.k0 = (u >> 5) * 64; c.n0 = (u & 31) * 256; c.src = p.w_up + (size_t)l * DM * DFF; c.ld = DFF; c.dst = p.WupT + (size_t)l * DFF * DM; c.Kd = DM; c.sc = c.n0 + 4 * lane; }
    else { u -= 1024; c.k0 = (u >> 3) * 64; c.n0 = (u & 7) * 256; c.src = p.w_down + (size_t)l * DFF * DM; c.ld = DM; c.dst = p.WdownT + (size_t)l * DM * DFF; c.Kd = DFF; c.sc = c.n0 + 4 * lane; }
    return c;
}
DI void convert_weights(const Params& p, char* shm, int t_begin, int t_end, int t_stride) {
    const int tid = tid_opaque(), lane = tid & 63, wv = tid >> 6;
    int t = t_begin;
    if (t >= t_end) return;
    ConvTile c = conv_tile(p, t, lane);
    f32x4 v[8];
#pragma unroll
    for (int e = 0; e < 8; ++e) { v[e][0] = v[e][1] = v[e][2] = v[e][3] = 0.f; if (c.sc >= 0) v[e] = *(const f32x4*)(c.src + (size_t)(c.k0 + 8 * wv + e) * c.ld + c.sc); }
    for (;;) {
#pragma unroll
        for (int j = 0; j < 4; ++j) {
            u32x4 pk; pk[0] = pk2(v[0][j], v[1][j]); pk[1] = pk2(v[2][j], v[3][j]); pk[2] = pk2(v[4][j], v[5][j]); pk[3] = pk2(v[6][j], v[7][j]);
            *(u32x4*)(shm + (4 * lane + j) * 144 + wv * 16) = pk;
        }
        const ConvTile cur = c;
        const int tn = t + t_stride; const bool more = tn < t_end;
        if (more) { c = conv_tile(p, tn, lane);
#pragma unroll
            for (int e = 0; e < 8; ++e) { v[e][0] = v[e][1] = v[e][2] = v[e][3] = 0.f; if (c.sc >= 0) v[e] = *(const f32x4*)(c.src + (size_t)(c.k0 + 8 * wv + e) * c.ld + c.sc); } }
        __syncthreads();
#pragma unroll
        for (int i = 0; i < 4; ++i) {
            const int q = tid + 512 * i, row = q >> 3, ch = q & 7;
            *(u32x4*)(cur.dst + (size_t)(cur.n0 + row) * cur.Kd + cur.k0 + ch * 8) = *(const u32x4*)(shm + row * 144 + ch * 16);
        }
        __syncthreads();
        if (!more) break;
        t = tn;
    }
}

DI void phase0(const Params& p, char* shm) {
    if (blockIdx.x == 0 && tid_opaque() < 32) p.ctr[tid_opaque()] = 0u;
    convert_weights(p, shm, (int)blockIdx.x, 6208, (int)gridDim.x);
    norm_rows(p.x_prompt, p.x_sample, nullptr, nullptr, 0, nullptr, p.g_mix_pre, nullptr, nullptr, p.H, 0, MT, (int)blockIdx.x, (int)gridDim.x);
}

template <class F>
DI void block_cumsum(int n, F load, float* cs, float* wt) {
    const int tid = tid_opaque(), lane = tid & 63, wid = tid >> 6;
    float v[5]; float s = 0.f;
#pragma unroll
    for (int j = 0; j < 5; ++j) { const int idx = tid * 5 + j; v[j] = idx < n ? load(idx) : 0.f; s += v[j]; }
    float inc = s;
#pragma unroll
    for (int o = 1; o < 64; o <<= 1) { const float t = __shfl_up(inc, o); if (lane >= o) inc += t; }
    if (lane == 63) wt[wid] = inc;
    __syncthreads();
    float run = inc - s;
    for (int w = 0; w < wid; ++w) run += wt[w];
#pragma unroll
    for (int j = 0; j < 5; ++j) { const int idx = tid * 5 + j; run += v[j]; if (idx < n) cs[idx] = run * LOG2E; }
    __syncthreads();
}

template <int NKT>
DI void fox_tile(const bf16_t* Ks, int ldk, const bf16_t* Vt, int ldv, const float* csl, int kpos0, int qpos, float cql,
                 const bf16x8 (&qf)[8], f32x16 (&o)[4], float& m, float& l, int r, int hh, bool need_mask) {
    constexpr float SC2 = 0.08838834764831845f * LOG2E;
    f32x16 x[NKT];
#pragma unroll
    for (int t2 = 0; t2 < NKT; ++t2) {
#pragma unroll
        for (int i = 0; i < 16; ++i) x[t2][i] = 0.f;
#pragma unroll
        for (int ks = 0; ks < 8; ++ks) { const bf16x8 a = *(const bf16x8*)(Ks + (t2 * 32 + r) * ldk + 16 * ks + 8 * hh); x[t2] = MFMA32(a, qf[ks], x[t2]); }
    }
    float mx = -1e30f;
#pragma unroll
    for (int t2 = 0; t2 < NKT; ++t2)
#pragma unroll
        for (int i = 0; i < 16; ++i) {
            const int kl = t2 * 32 + crow(i, hh);
            const f32x4 c4 = *(const f32x4*)(csl + t2 * 32 + 8 * (i >> 2) + 4 * hh);
            float v = fmaf(x[t2][i], SC2, cql - c4[i & 3]);
            if (need_mask) v = (kpos0 + kl <= qpos) ? v : -1e30f;
            x[t2][i] = v; mx = fmaxf(mx, v);
        }
    mx = fmaxf(mx, __shfl_xor(mx, 32));
    const float mn = fmaxf(m, mx), alpha = __builtin_amdgcn_exp2f(m - mn);
    m = mn;
    float ls = 0.f;
#pragma unroll
    for (int t2 = 0; t2 < NKT; ++t2)
#pragma unroll
        for (int i = 0; i < 16; ++i) { const float pv = __builtin_amdgcn_exp2f(x[t2][i] - mn); x[t2][i] = pv; ls += pv; }
    l = l * alpha + ls;
    if (__builtin_amdgcn_ballot_w64(alpha != 1.0f) != 0ull) {
#pragma unroll
        for (int dt = 0; dt < 4; ++dt)
#pragma unroll
            for (int i = 0; i < 16; ++i) o[dt][i] *= alpha;
    }
#pragma unroll
    for (int t2 = 0; t2 < NKT; ++t2)
#pragma unroll
        for (int s = 0; s < 2; ++s) {
            u32x4 pp; pp[0] = pk2(x[t2][8 * s + 0], x[t2][8 * s + 1]); pp[1] = pk2(x[t2][8 * s + 2], x[t2][8 * s + 3]);
            pp[2] = pk2(x[t2][8 * s + 4], x[t2][8 * s + 5]); pp[3] = pk2(x[t2][8 * s + 6], x[t2][8 * s + 7]);
            const bf16x8 pf = __builtin_bit_cast(bf16x8, pp);
#pragma unroll
            for (int dt = 0; dt < 4; ++dt) {
                const bf16_t* vp = Vt + (dt * 32 + r) * ldv + t2 * 32 + 16 * s + 4 * hh;
                const s16x4 lo = *(const s16x4*)vp, hi = *(const s16x4*)(vp + 8);
                const bf16x8 a = __builtin_shufflevector(lo, hi, 0, 1, 2, 3, 4, 5, 6, 7);
                o[dt] = MFMA32(a, pf, o[dt]);
            }
        }
}

DI void fox_prompt_item(const Params& p, int l, int b, int h, int qb, char* shm) {
    bf16_t* Ks = (bf16_t*)shm; bf16_t* Vt = (bf16_t*)(shm + 17408); float* cs = (float*)(shm + 143360); float* wt = (float*)(shm + 151680);
    const int tid = tid_opaque(), wid = tid >> 6, lane = tid & 63, r = lane & 31, hh = lane >> 5;
    const int nkeys = (qb + 1) * 256;
    const float* lf = p.EX + ((size_t)b * 2048) * 32 + 16 + h; const float fb = p.b_fox_f[l * 8 + h];
    block_cumsum(nkeys, [&](int i) { return logsig(lf[(size_t)i * 32] + fb); }, cs, wt);
    const int qpos = qb * 256 + wid * 32 + r; const size_t qrow = (size_t)b * 2048 + qpos;
    bf16x8 qf[8];
    { const bf16_t* zq = p.Z + qrow * NZ + 3072 + h * 128;
#pragma unroll
      for (int ks = 0; ks < 8; ++ks) qf[ks] = *(const bf16x8*)(zq + 16 * ks + 8 * hh); }
    const float cql = cs[qpos];
    f32x16 o[4];
#pragma unroll
    for (int dt = 0; dt < 4; ++dt)
#pragma unroll
        for (int i = 0; i < 16; ++i) o[dt][i] = 0.f;
    float m = -1e30f, lsum = 0.f;
    const int nt = (qb + 1) * 4;
    const bf16_t* zk = p.Z + (size_t)b * 2048 * NZ + 4096 + h * 128; const bf16_t* zv = zk + 1024;
    int krow_[2], kc8[2], vrow[2], vc8[2];
#pragma unroll
    for (int i = 0; i < 2; ++i) { const int q = tid + 512 * i; krow_[i] = q >> 4; kc8[i] = (q & 15) * 8; const int wv = q >> 6, ln = q & 63; vrow[i] = (wv & 3) * 16 + (ln & 15); vc8[i] = ((wv >> 2) * 4 + (ln >> 4)) * 8; }
    u32x4 kreg[2], vreg[2];
#pragma unroll
    for (int i = 0; i < 2; ++i) { kreg[i] = *(const u32x4*)(zk + (size_t)((nt - 1) * 64 + krow_[i]) * NZ + kc8[i]); vreg[i] = *(const u32x4*)(zv + (size_t)((nt - 1) * 64 + vrow[i]) * NZ + vc8[i]); }
    const int qmaxw = qb * 256 + wid * 32 + 31, qminw = qb * 256 + wid * 32;
    for (int kt = nt - 1; kt >= 0; --kt) {
        __syncthreads();
#pragma unroll
        for (int i = 0; i < 2; ++i) {
            *(u32x4*)(Ks + krow_[i] * 136 + kc8[i]) = kreg[i];
#pragma unroll
            for (int e = 0; e < 4; ++e) { const unsigned w = vreg[i][e]; Vt[(vc8[i] + 2 * e) * 68 + vrow[i]] = (bf16_t)(w & 0xffffu); Vt[(vc8[i] + 2 * e + 1) * 68 + vrow[i]] = (bf16_t)(w >> 16); }
        }
        __syncthreads();
        if (kt > 0) {
#pragma unroll
            for (int i = 0; i < 2; ++i) { kreg[i] = *(const u32x4*)(zk + (size_t)((kt - 1) * 64 + krow_[i]) * NZ + kc8[i]); vreg[i] = *(const u32x4*)(zv + (size_t)((kt - 1) * 64 + vrow[i]) * NZ + vc8[i]); }
        }
        if (kt * 64 <= qmaxw) fox_tile<2>(Ks, 136, Vt, 68, cs + kt * 64, kt * 64, qpos, cql, qf, o, m, lsum, r, hh, kt * 64 + 63 > qminw);
    }
    const float lt = lsum + __shfl_xor(lsum, 32); const float inv = 1.0f / lt;
    bf16_t* mo = p.MRG + qrow * DM + 1024 + h * 128;
#pragma unroll
    for (int dt = 0; dt < 4; ++dt)
#pragma unroll
        for (int g = 0; g < 4; ++g) {
            u32x2 pk; pk[0] = pk2(o[dt][4 * g] * inv, o[dt][4 * g + 1] * inv); pk[1] = pk2(o[dt][4 * g + 2] * inv, o[dt][4 * g + 3] * inv);
            *(u32x2*)(mo + dt * 32 + 8 * g + 4 * hh) = pk;
        }
}

DI float logsig_fast(float x) { return fminf(x, 0.f) - 0.6931471805599453f * __builtin_amdgcn_logf(1.0f + __builtin_amdgcn_exp2f(-fabsf(x) * LOG2E)); }
DI float exp_fast(float x) { return __builtin_amdgcn_exp2f(x * LOG2E); }

DI void gla_a_item(const Params& p, int l, int it, char* shm) {
    bf16_t* Qi = (bf16_t*)shm; bf16_t* Ki = (bf16_t*)(shm + 17408); bf16_t* Ket = (bf16_t*)(shm + 34816); bf16_t* At = (bf16_t*)(shm + 53248);
    float* dec = (float*)(shm + 62464); float* tot = (float*)(shm + 62976); bf16_t* Vt = (bf16_t*)(shm + 65024);
    float* glr = (float*)(shm + 101888); bf16_t* Qraw = (bf16_t*)(shm + 105984); bf16_t* Kraw = (bf16_t*)(shm + 122368);
    const int tid = tid_opaque(), wid = tid >> 6, lane = tid & 63, r = lane & 31, hh = lane >> 5;
    const int grp = it >= 512 ? 1 : 0;
    const int h = grp ? (it & 3) : ((it >> 5) & 3);
    const int nvalid = grp ? 32 : 64;
    const size_t rowc = grp ? (size_t)NP + (size_t)((it - 512) >> 2) * 32 : (size_t)(it >> 7) * 2048 + (size_t)(it & 31) * 64;
    const int d = tid & 127, sg = tid >> 7;
    float w2[16];
#pragma unroll
    for (int k = 0; k < 16; ++k) w2[k] = p.w_gate_up[((size_t)l * 16 + k) * 512 + h * 128 + d];
    const float bias = p.b_gate[(size_t)l * 512 + h * 128 + d];
    if (tid < 256) {
        const int s = tid >> 2, part = tid & 3; f32x4 v; v[0] = v[1] = v[2] = v[3] = 0.f;
        if (s < nvalid) v = *(const f32x4*)(p.EX + (rowc + s) * 32 + part * 4);
        *(f32x4*)(glr + s * 16 + part * 4) = v;
    }
#pragma unroll
    for (int i = 0; i < 2; ++i) {
        const int q = tid + 512 * i, row = q >> 4, c8 = (q & 15) * 8;
        u32x4 qv, kv; qv[0] = qv[1] = qv[2] = qv[3] = 0u; kv = qv;
        if (row < nvalid) { const bf16_t* zr = p.Z + (rowc + row) * NZ + h * 128 + c8; qv = *(const u32x4*)zr; kv = *(const u32x4*)(zr + 512); }
        *(u32x4*)(Qraw + row * 128 + c8) = qv; *(u32x4*)(Kraw + row * 128 + c8) = kv;
    }
    __syncthreads();
    float gv[16]; float cum = 0.f;
#pragma unroll
    for (int i = 0; i < 16; ++i) {
        const int s = sg * 16 + i; float gl = 0.f;
        if (s < nvalid) {
            const float* e = glr + s * 16; float x = bias;
#pragma unroll
            for (int k4 = 0; k4 < 4; ++k4) { const f32x4 ev = *(const f32x4*)(e + 4 * k4); x += ev[0] * w2[4 * k4] + ev[1] * w2[4 * k4 + 1] + ev[2] * w2[4 * k4 + 2] + ev[3] * w2[4 * k4 + 3]; }
            gl = logsig_fast(x) * 0.0625f;
        }
        cum += gl; gv[i] = cum;
    }
    tot[sg * 128 + d] = cum;
#pragma unroll
    for (int i = 0; i < 2; ++i) {
        const int q = tid + 512 * i, wv = q >> 6, ln = q & 63, pr = (wv & 1) * 16 + (ln & 15), pc = (wv >> 1) * 4 + (ln >> 4);
        u32x4 va, vb; va[0] = va[1] = va[2] = va[3] = 0u; vb = va;
        if (2 * pr < nvalid) { const bf16_t* zr = p.Z + (rowc + 2 * pr) * NZ + 1024 + h * 256 + pc * 8; va = *(const u32x4*)zr; vb = *(const u32x4*)(zr + NZ); }
        unsigned* vd = (unsigned*)Vt;
#pragma unroll
        for (int e = 0; e < 4; ++e) {
            vd[((pc * 8 + 2 * e) * 72 + 2 * pr) >> 1] = (va[e] & 0xffffu) | (vb[e] << 16);
            vd[((pc * 8 + 2 * e + 1) * 72 + 2 * pr) >> 1] = (va[e] >> 16) | (vb[e] & 0xffff0000u);
        }
    }
    __syncthreads();
    float off = 0.f;
    for (int g = 0; g < sg; ++g) off += tot[g * 128 + d];
    const float blast = tot[d] + tot[128 + d] + tot[256 + d] + tot[384 + d];
    {
        float kev[16];
#pragma unroll
        for (int i = 0; i < 16; ++i) {
            const int s = sg * 16 + i; const float bb = off + gv[i]; float q = 0.f, k = 0.f;
            q = bf2f(Qraw[s * 128 + d]); k = bf2f(Kraw[s * 128 + d]);
            const bf16_t qi = f2bf(q * exp_fast(bb));
            Qi[s * 136 + d] = qi; Ki[s * 136 + d] = f2bf(k * exp_fast(-bb)); kev[i] = k * exp_fast(blast - bb);
        }
        u32x4 p0, p1;
        p0[0] = pk2(kev[0], kev[1]); p0[1] = pk2(kev[2], kev[3]); p0[2] = pk2(kev[4], kev[5]); p0[3] = pk2(kev[6], kev[7]);
        p1[0] = pk2(kev[8], kev[9]); p1[1] = pk2(kev[10], kev[11]); p1[2] = pk2(kev[12], kev[13]); p1[3] = pk2(kev[14], kev[15]);
        *(u32x4*)(Ket + d * 72 + sg * 16) = p0; *(u32x4*)(Ket + d * 72 + sg * 16 + 8) = p1;
        if (sg == 0) p.DEC[(size_t)it * 128 + d] = exp_fast(blast);
    }
    __syncthreads();
#pragma unroll
    for (int i = 0; i < 2; ++i) {
        const int q = tid + 512 * i, row = q >> 4, c8 = (q & 15) * 8;
        if (row < nvalid) *(u32x4*)(p.QI + (rowc + row) * 512 + h * 128 + c8) = *(const u32x4*)(Qi + row * 136 + c8);
    }
    if (wid < 3) {
        const int si = wid == 2 ? 1 : 0, ci = wid >= 1 ? 1 : 0;
        f32x16 x;
#pragma unroll
        for (int i = 0; i < 16; ++i) x[i] = 0.f;
#pragma unroll
        for (int ks = 0; ks < 8; ++ks) {
            const bf16x8 a = *(const bf16x8*)(Ki + (si * 32 + r) * 136 + 16 * ks + 8 * hh);
            const bf16x8 bq = *(const bf16x8*)(Qi + (ci * 32 + r) * 136 + 16 * ks + 8 * hh);
            x = MFMA32(a, bq, x);
        }
        const int c = ci * 32 + r;
#pragma unroll
        for (int g = 0; g < 4; ++g) {
            float v[4];
#pragma unroll
            for (int e = 0; e < 4; ++e) { const int s = si * 32 + 8 * g + 4 * hh + e; v[e] = s <= c ? x[4 * g + e] : 0.f; }
            u32x2 pk; pk[0] = pk2(v[0], v[1]); pk[1] = pk2(v[2], v[3]);
            *(u32x2*)(At + c * 72 + si * 32 + 8 * g + 4 * hh) = pk;
        }
    }
    __syncthreads();
    {
        bf16x8 av[4];
#pragma unroll
        for (int ks = 0; ks < 4; ++ks) av[ks] = *(const bf16x8*)(Vt + (wid * 32 + r) * 72 + 16 * ks + 8 * hh);
#pragma unroll
        for (int ci = 0; ci < 2; ++ci) {
            if (ci * 32 < nvalid) {
                f32x16 oa;
#pragma unroll
                for (int i = 0; i < 16; ++i) oa[i] = 0.f;
#pragma unroll
                for (int ks = 0; ks < 4; ++ks) {
                    if (ks < (ci ? 4 : 2)) { const bf16x8 bq = *(const bf16x8*)(At + (ci * 32 + r) * 72 + 16 * ks + 8 * hh); oa = MFMA32(av[ks], bq, oa); }
                }
                bf16_t* og = (bf16_t*)p.OG + (rowc + ci * 32 + r) * 1024 + h * 256 + wid * 32 + 4 * hh;
#pragma unroll
                for (int g = 0; g < 4; ++g) { u32x2 pk; pk[0] = pk2(oa[4 * g], oa[4 * g + 1]); pk[1] = pk2(oa[4 * g + 2], oa[4 * g + 3]); *(u32x2*)(og + 8 * g) = pk; }
            }
        }
        bf16_t* kvt = (bf16_t*)p.KVT + (size_t)it * 32768;
#pragma unroll
        for (int di = 0; di < 4; ++di) {
            f32x16 acc;
#pragma unroll
            for (int i = 0; i < 16; ++i) acc[i] = 0.f;
#pragma unroll
            for (int ks = 0; ks < 4; ++ks) { const bf16x8 bq = *(const bf16x8*)(Ket + (di * 32 + r) * 72 + 16 * ks + 8 * hh); acc = MFMA32(bq, av[ks], acc); }
#pragma unroll
            for (int g = 0; g < 4; ++g) { u32x2 pk; pk[0] = pk2(acc[4 * g], acc[4 * g + 1]); pk[1] = pk2(acc[4 * g + 2], acc[4 * g + 3]); *(u32x2*)(kvt + (wid * 32 + r) * 128 + di * 32 + 8 * g + 4 * hh) = pk; }
        }
    }
}

DI void gla_scan(const Params& p, int l) {
    const int tid = tid_opaque();
    for (int idx = blockIdx.x * 512 + tid; idx < MT * 8; idx += gridDim.x * 512) {
        const int row = idx >> 3, hd = idx & 7; const float lf = logsig(p.EX[(size_t)row * 32 + 16 + hd] + p.b_fox_f[l * 8 + hd]);
        if (row < NP) p.out[O_LFP + ((size_t)l * NP + row) * 8 + hd] = lf; else p.out[O_LFS + ((size_t)l * NS + row - NP) * 8 + hd] = lf;
    }
    for (int t = blockIdx.x; t < 768; t += gridDim.x) {
        const int grp = t >= 256 ? 1 : 0, u = grp ? t - 256 : t, seq = u >> 4, vt = u & 15;
        const int nch = grp ? 1 : 32, item0 = grp ? 512 + seq : seq * 32;
        const int v = vt * 16 + (tid & 15), d0 = (tid >> 4) * 4;
        float S[4];
        if (grp) {
            const float* sin = p.state_gla + (((size_t)l * 32 + seq) * 128 + d0) * 256 + v;
#pragma unroll
            for (int j = 0; j < 4; ++j) S[j] = sin[(size_t)j * 256];
        } else {
#pragma unroll
            for (int j = 0; j < 4; ++j) S[j] = 0.f;
        }
#pragma unroll 8
        for (int n = 0; n < nch; ++n) {
            const size_t it = (size_t)(item0 + n);
            u32x2 pk; pk[0] = pk2(S[0], S[1]); pk[1] = pk2(S[2], S[3]);
            *(u32x2*)(p.SS + it * 32768 + (size_t)v * 128 + d0) = pk;
            const u32x2 kb = *(const u32x2*)((const bf16_t*)p.KVT + it * 32768 + (size_t)v * 128 + d0); const f32x4 c0 = *(const f32x4*)(p.DEC + it * 128 + d0);
            f32x4 k0; k0[0] = bflo(kb[0]); k0[1] = bfhi(kb[0]); k0[2] = bflo(kb[1]); k0[3] = bfhi(kb[1]);
#pragma unroll
            for (int j = 0; j < 4; ++j) S[j] = c0[j] * S[j] + k0[j];
        }
        float* so = (grp ? p.out + O_STS + (((size_t)l * 32 + seq) * 128 + d0) * 256 : p.out + O_STP + (((size_t)l * 16 + seq) * 128 + d0) * 256) + v;
#pragma unroll
        for (int j = 0; j < 4; ++j) so[(size_t)j * 256] = S[j];
    }
}

DI void gla_c_stage(const Params& p, int l, char* shm) {
    const int tid = tid_opaque(), wid = tid >> 6, lane = tid & 63, r = lane & 31, hh = lane >> 5;
    for (int wt = wid * (int)gridDim.x + (int)blockIdx.x; wt < 1088; wt += 8 * (int)gridDim.x) {
        const int it = wt >> 1, ci = wt & 1;
        const int grp = it >= 512 ? 1 : 0;
        if (grp && ci) continue;
        const int h = grp ? (it & 3) : ((it >> 5) & 3);
        const size_t rowc = grp ? (size_t)NP + (size_t)((it - 512) >> 2) * 32 : (size_t)(it >> 7) * 2048 + (size_t)(it & 31) * 64;
        const size_t row = rowc + ci * 32 + r;
        bf16x8 bq[8];
#pragma unroll
        for (int ks = 0; ks < 8; ++ks) bq[ks] = *(const bf16x8*)(p.QI + row * 512 + h * 128 + 16 * ks + 8 * hh);
        f32x16 acc[8];
        float ss = 0.f;
#pragma unroll
        for (int vt = 0; vt < 8; ++vt) {
            const bf16_t* og = (const bf16_t*)p.OG + row * 1024 + h * 256 + vt * 32 + 4 * hh;
#pragma unroll
            for (int g = 0; g < 4; ++g) { const u32x2 v = *(const u32x2*)(og + 8 * g); acc[vt][4 * g] = bflo(v[0]); acc[vt][4 * g + 1] = bfhi(v[0]); acc[vt][4 * g + 2] = bflo(v[1]); acc[vt][4 * g + 3] = bfhi(v[1]); }
            const bf16_t* ssp = p.SS + (size_t)it * 32768 + (size_t)(vt * 32 + r) * 128 + 8 * hh;
#pragma unroll
            for (int ks = 0; ks < 8; ++ks) { const bf16x8 a = *(const bf16x8*)(ssp + 16 * ks); acc[vt] = MFMA32(a, bq[ks], acc[vt]); }
#pragma unroll
            for (int i = 0; i < 16; ++i) ss += acc[vt][i] * acc[vt][i];
        }
        ss += __shfl_xor(ss, 32);
        const float rs = rsqrtf(ss * (1.0f / 256.0f) + EPS);
#pragma unroll
        for (int vt = 0; vt < 8; ++vt) {
            const int vc = h * 256 + vt * 32 + 4 * hh;
#pragma unroll
            for (int g = 0; g < 4; ++g) {
                const f32x4 gn = *(const f32x4*)(p.g_onorm + (size_t)l * 1024 + vc + 8 * g);
                const u32x2 rg = *(const u32x2*)(p.Z + row * NZ + 2048 + vc + 8 * g);
                const float r0 = bflo(rg[0]), r1 = bfhi(rg[0]), r2 = bflo(rg[1]), r3 = bfhi(rg[1]);
                const float o0 = acc[vt][4 * g] * rs * gn[0] * (r0 / (1.0f + exp_fast(-r0))), o1 = acc[vt][4 * g + 1] * rs * gn[1] * (r1 / (1.0f + exp_fast(-r1)));
                const float o2 = acc[vt][4 * g + 2] * rs * gn[2] * (r2 / (1.0f + exp_fast(-r2))), o3 = acc[vt][4 * g + 3] * rs * gn[3] * (r3 / (1.0f + exp_fast(-r3)));
                u32x2 pk; pk[0] = pk2(o0, o1); pk[1] = pk2(o2, o3);
                *(u32x2*)(p.MRG + row * DM + vc + 8 * g) = pk;
            }
        }
    }
}

DI void fox_sample_item(const Params& p, int l, int b, int h, int sp, char* shm) {
    float* cs = (float*)(shm + 143360); float* wt = (float*)(shm + 151680);
    const int tid = tid_opaque(), wid = tid >> 6, lane = tid & 63, r = lane & 31, hh = lane >> 5;
    const float* lfc = p.cache_logf + ((size_t)(l * 8 + b) * 2048) * 8 + h;
    const float* lfn = p.EX + ((size_t)NP + b * 32) * 32 + 16 + h; const float fb = p.b_fox_f[l * 8 + h];
    block_cumsum(2080, [&](int i) { return i < 2048 ? lfc[(size_t)i * 8] : logsig(lfn[(size_t)(i - 2048) * 32] + fb); }, cs, wt);
    const int qpos = 2048 + r; const size_t qrow = (size_t)NP + b * 32 + r;
    bf16x8 qf[8];
    { const bf16_t* zq = p.Z + qrow * NZ + 3072 + h * 128;
#pragma unroll
      for (int ks = 0; ks < 8; ++ks) qf[ks] = *(const bf16x8*)(zq + 16 * ks + 8 * hh); }
    const float cql = cs[qpos];
    f32x16 o[4];
#pragma unroll
    for (int dt = 0; dt < 4; ++dt)
#pragma unroll
        for (int i = 0; i < 16; ++i) o[dt][i] = 0.f;
    float m = -1e30f, lsum = 0.f;
    bf16_t* Ks = (bf16_t*)(shm + wid * 17920); bf16_t* Vt = (bf16_t*)(shm + wid * 17920 + 8704);
    const int jend = sp * 17 + 17 < 65 ? sp * 17 + 17 : 65;
    for (int j = sp * 17 + wid; j < jend; j += 8) {
        const float* srcK = j < 64 ? p.cache_k + (((size_t)(l * 8 + b) * 2048 + (size_t)j * 32) * 8 + h) * 128 : p.out + O_KS + (((size_t)(l * 8 + b) * 32) * 8 + h) * 128;
        const float* srcV = j < 64 ? p.cache_v + (((size_t)(l * 8 + b) * 2048 + (size_t)j * 32) * 8 + h) * 128 : p.out + O_VS + (((size_t)(l * 8 + b) * 32) * 8 + h) * 128;
        {
            const int prow = lane >> 5, pc4 = (lane & 31) * 4;
            f32x4 kr[16], va[4];
#pragma unroll
            for (int i = 0; i < 16; ++i) kr[i] = *(const f32x4*)(srcK + (size_t)(2 * i + prow) * 1024 + pc4);
#pragma unroll
            for (int i = 0; i < 4; ++i) va[i] = *(const f32x4*)(srcV + (size_t)(2 * i + prow) * 1024 + pc4);
#pragma unroll
            for (int i = 0; i < 16; ++i) { u32x2 pk; pk[0] = pk2(kr[i][0], kr[i][1]); pk[1] = pk2(kr[i][2], kr[i][3]); *(u32x2*)(Ks + (2 * i + prow) * 136 + pc4) = pk; }
            asm volatile("" ::: "memory");
            f32x4 vb[12];
#pragma unroll
            for (int i = 0; i < 12; ++i) vb[i] = *(const f32x4*)(srcV + (size_t)(2 * (i + 4) + prow) * 1024 + pc4);
#pragma unroll
            for (int i = 0; i < 4; ++i) {
#pragma unroll
                for (int e = 0; e < 4; ++e) Vt[(pc4 + e) * 36 + 2 * i + prow] = f2bf(va[i][e]);
            }
#pragma unroll
            for (int i = 0; i < 12; ++i) {
#pragma unroll
                for (int e = 0; e < 4; ++e) Vt[(pc4 + e) * 36 + 2 * (i + 4) + prow] = f2bf(vb[i][e]);
            }
        }
        fox_tile<1>(Ks, 136, Vt, 36, cs + j * 32, j * 32, qpos, cql, qf, o, m, lsum, r, hh, j == 64);
    }
    const float lt = lsum + __shfl_xor(lsum, 32);
    __syncthreads();
    float* ml = wt;
    if (hh == 0) { ml[(wid * 32 + r) * 2] = m; ml[(wid * 32 + r) * 2 + 1] = lt; }
    __syncthreads();
    float M = -1e30f;
#pragma unroll
    for (int w = 0; w < 8; ++w) M = fmaxf(M, ml[(w * 32 + r) * 2]);
    float L = 0.f;
#pragma unroll
    for (int w = 0; w < 8; ++w) L += __builtin_amdgcn_exp2f(ml[(w * 32 + r) * 2] - M) * ml[(w * 32 + r) * 2 + 1];
    const float f = __builtin_amdgcn_exp2f(m - M);
    float* ow = (float*)shm + wid * (32 * 132);
#pragma unroll
    for (int dt = 0; dt < 4; ++dt)
#pragma unroll
        for (int g = 0; g < 4; ++g) {
            f32x4 v; v[0] = o[dt][4 * g] * f; v[1] = o[dt][4 * g + 1] * f; v[2] = o[dt][4 * g + 2] * f; v[3] = o[dt][4 * g + 3] * f;
            *(f32x4*)(ow + r * 132 + dt * 32 + 8 * g + 4 * hh) = v;
        }
    const int slot = ((b * 8 + h) * 4 + sp);
    if (wid == 0 && hh == 0) { p.FSML[(size_t)(slot * 32 + r) * 2] = M; p.FSML[(size_t)(slot * 32 + r) * 2 + 1] = L; }
    __syncthreads();
    {
        const int q = tid >> 4, d8 = (tid & 15) * 8; float acc[8];
#pragma unroll
        for (int e = 0; e < 8; ++e) acc[e] = 0.f;
#pragma unroll
        for (int w = 0; w < 8; ++w) {
            const float* src = (const float*)shm + w * (32 * 132) + q * 132 + d8;
            const f32x4 a = *(const f32x4*)src, c = *(const f32x4*)(src + 4);
#pragma unroll
            for (int e = 0; e < 4; ++e) { acc[e] += a[e]; acc[4 + e] += c[e]; }
        }
        float* dst = p.FSO + ((size_t)slot * 32 + q) * 128 + d8;
        f32x4 v0, v1; v0[0] = acc[0]; v0[1] = acc[1]; v0[2] = acc[2]; v0[3] = acc[3]; v1[0] = acc[4]; v1[1] = acc[5]; v1[2] = acc[6]; v1[3] = acc[7];
        *(f32x4*)dst = v0; *(f32x4*)(dst + 4) = v1;
    }
}

DI void fox_sample_combine(const Params& p) {
    for (int idx = blockIdx.x * 512 + tid_opaque(); idx < 64 * 32 * 16; idx += gridDim.x * 512) {
        const int d8 = (idx & 15) * 8, q = (idx >> 4) & 31, bh = idx >> 9;
        float ms[4], ls[4], M = -1e30f;
#pragma unroll
        for (int s = 0; s < 4; ++s) { ms[s] = p.FSML[(size_t)((bh * 4 + s) * 32 + q) * 2]; ls[s] = p.FSML[(size_t)((bh * 4 + s) * 32 + q) * 2 + 1]; M = fmaxf(M, ms[s]); }
        float L = 0.f, acc[8];
#pragma unroll
        for (int e = 0; e < 8; ++e) acc[e] = 0.f;
#pragma unroll
        for (int s = 0; s < 4; ++s) {
            const float w = __builtin_amdgcn_exp2f(ms[s] - M); L += w * ls[s];
            const float* src = p.FSO + ((size_t)(bh * 4 + s) * 32 + q) * 128 + d8;
            const f32x4 a = *(const f32x4*)src, c = *(const f32x4*)(src + 4);
#pragma unroll
            for (int e = 0; e < 4; ++e) { acc[e] += w * a[e]; acc[4 + e] += w * c[e]; }
        }
        const float inv = 1.0f / L;
        u32x4 pk; pk[0] = pk2(acc[0] * inv, acc[1] * inv); pk[1] = pk2(acc[2] * inv, acc[3] * inv); pk[2] = pk2(acc[4] * inv, acc[5] * inv); pk[3] = pk2(acc[6] * inv, acc[7] * inv);
        *(u32x4*)(p.MRG + ((size_t)NP + (bh >> 3) * 32 + q) * DM + 1024 + (bh & 7) * 128 + d8) = pk;
    }
}

DI int pop_item(unsigned* ctr, char* shm) {
    volatile int* sitem = (volatile int*)(shm + LDS_ITEM_OFF);
    __syncthreads();
    if (tid_opaque() == 0) *sitem = (int)atomicAdd(ctr, 1u);
    __syncthreads();
    return *sitem;
}
template <int WHICH>
DI void mixer_phase(const Params& p, int l, char* shm, int coff) {
    if constexpr (WHICH & 1) for (;;) {
        const int j = pop_item(p.ctr + coff + l * 4 + 1, shm);
        if (j >= 256) break;
        fox_prompt_item(p, l, (j & 31) >> 3, j & 7, 7 - (j >> 5), shm);
    }
    if constexpr (WHICH == 7) for (;;) {
        const int j = pop_item(p.ctr + 16 + l, shm);
        if (j >= (33 - RG_IN) * 4) break;
        EpiIn E; E.Z = p.Z; E.EX = p.EX; E.row_base = RG_IN * 256; E.pn_base = 8; E.outk_p = E.outv_p = E.outk_s = E.outv_s = nullptr;
        run_gemm(shm, p.H + (size_t)RG_IN * 256 * DM, p.WinT + (size_t)l * NIN * DM + (size_t)2048 * DM, (33 - RG_IN) * 256, 1024, DM, DM, DM, 1, E, (33 - RG_IN) * 4, j);
    }
    if constexpr (WHICH & 2) for (;;) {
        const int j = pop_item(p.ctr + coff + l * 4 + 2, shm);
        if (j >= 256) break;
        fox_sample_item(p, l, j >> 5, (j >> 2) & 7, j & 3, shm);
    }
    if constexpr (WHICH & 4) for (;;) {
        const int item = pop_item(p.ctr + coff + l * 4 + 0, shm);
        if (item >= 544) break;
        gla_a_item(p, l, item, shm);
    }
}

constexpr int NPHASE = 17;
constexpr int SPLIT_OUT = 8, SPLIT_DOWN = 16;
template <int S>
DI void run_stage(const Params& p, int l, char* shm) {
    float* yp = p.out + O_YP; float* ys = p.out + O_YS;
    if constexpr (S == 8) { phase0(p, shm); }
    if constexpr (S == 0) { EpiIn E; E.Z = p.Z; E.EX = p.EX; E.row_base = 0; E.pn_base = 0; E.outk_p = p.out + O_KP + (size_t)l * NP * 1024; E.outv_p = p.out + O_VP + (size_t)l * NP * 1024;
              E.outk_s = p.out + O_KS + (size_t)l * NS * 1024; E.outv_s = p.out + O_VS + (size_t)l * NS * 1024;
              pg8::Gemm g; g.A = p.H; g.Bt = p.WinT + (size_t)l * NIN * DM; g.M = MT; g.N = NIN; g.K = DM; g.lda = DM; g.ldb = DM; g.nct = NIN / 256; g.ksub = DM;
              InOrder S0; S0.init((int)gridDim.x, (int)blockIdx.x);
              pg8::gemm_phase<EpiIn, InOrder, false>((PG8_LAS unsigned char*)shm, g, S0, E, nullptr); }
    if constexpr (S == 1) mixer_phase<7>(p, l, shm, 0);
#if defined(PROBE) && PROBE >= 3 && PROBE <= 5
    if constexpr (S == 9) mixer_phase<(PROBE == 3 ? 1 : PROBE == 4 ? 2 : 4)>(p, l, shm, 8);
#endif
    if constexpr (S == 12) mixer_phase<7>(p, l, shm, 8);
    if constexpr (S == 2) { fox_sample_combine(p); gla_scan(p, l); }
    if constexpr (S == 10) gla_c_stage(p, l, shm);
    if constexpr (S == 3) { EpiRaw E; E.C = p.RAW; run_gemm(shm, p.MRG, p.WoutT + (size_t)l * DM * DM, NP, DM, DM, DM, DM, 1, E);
              EpiPart EP; EP.P = (bf16_t*)p.PART; run_gemm(shm, p.MRG + (size_t)NP * DM, p.WoutT + (size_t)l * DM * DM, NS, DM, DM / SPLIT_OUT, DM, DM, SPLIT_OUT, EP); }
    if constexpr (S == 14)
        norm_rows(l == 0 ? p.x_prompt : yp, l == 0 ? p.x_sample : ys, p.RAW, p.PART, SPLIT_OUT, p.g_mix_post + (size_t)l * DM, p.g_mlp_pre + (size_t)l * DM, yp, ys, p.H, NP, MT, (int)blockIdx.x, (int)gridDim.x, true, l == 0 ? nullptr : p.YB, p.YB);
    if constexpr (S == 4) {
        const int ng = (int)gridDim.x - 32;
        if ((int)blockIdx.x >= ng) { EpiUp E; E.U = p.U + (size_t)NP * DFF; run_gemm(shm, p.H + (size_t)NP * DM, p.WupT + (size_t)l * DFF * DM, NS, DFF, DM, DM, DM, 1, E, 32, (int)blockIdx.x - ng); }
        else norm_rows(l == 0 ? p.x_prompt : yp, l == 0 ? p.x_sample : ys, p.RAW, p.PART, SPLIT_OUT, p.g_mix_post + (size_t)l * DM, p.g_mlp_pre + (size_t)l * DM, yp, ys, p.H, 0, NP, (int)blockIdx.x, ng, false, l == 0 ? nullptr : p.YB, p.YB);
    }
    if constexpr (S == 5) { EpiUp E; E.U = p.U; run_gemm(shm, p.H, p.WupT + (size_t)l * DFF * DM, NP, DFF, DM, DM, DM, 1, E); }
    if constexpr (S == 6) { EpiRaw E; E.C = p.RAW; run_gemm(shm, p.U, p.WdownT + (size_t)l * DM * DFF, NP, DM, DFF, DFF, DFF, 1, E);
              EpiPart EP; EP.P = (bf16_t*)p.PART; run_gemm(shm, p.U + (size_t)NP * DFF, p.WdownT + (size_t)l * DM * DFF, NS, DM, DFF / SPLIT_DOWN, DFF, DFF, SPLIT_DOWN, EP); }
    if constexpr (S == 7) {
        const float* gn = l + 1 < 2 ? p.g_mix_pre + (size_t)(l + 1) * DM : nullptr;
        norm_rows(yp, ys, p.RAW, p.PART, SPLIT_DOWN, p.g_mlp_post + (size_t)l * DM, gn, yp, ys, p.H, NP, MT, (int)blockIdx.x, (int)gridDim.x, true, p.YB, l + 1 < 2 ? p.YB : nullptr);
        norm_rows(yp, ys, p.RAW, p.PART, SPLIT_DOWN, p.g_mlp_post + (size_t)l * DM, gn, yp, ys, p.H, 0, NP, (int)blockIdx.x, (int)gridDim.x, false, p.YB, l + 1 < 2 ? p.YB : nullptr);
    }
}

#if MEGA
DI Params load_params() {
    Params r{};
#if defined(__HIP_DEVICE_COMPILE__)
    const __attribute__((address_space(4))) unsigned long long* kp = (const __attribute__((address_space(4))) unsigned long long*)__builtin_amdgcn_kernarg_segment_ptr();
    asm volatile("" : "+s"(kp));
    unsigned long long* d = (unsigned long long*)&r;
#pragma unroll
    for (int i = 0; i < (int)(sizeof(Params) / 8); ++i) d[i] = kp[i];
#endif
    return r;
}
__global__ void __launch_bounds__(512, 2) k_mega(Params p_unused) {
    extern __shared__ __attribute__((aligned(16))) char shm[];
    cg::grid_group grid = cg::this_grid();
    volatile LAS unsigned* st = (volatile LAS unsigned*)(shm + LDS_ITEM_OFF + 16);
    if (threadIdx.x < 2) st[threadIdx.x] = 0u;
    __syncthreads();
    XcdBarrier bar;
    { const Params q = load_params(); bar = xcd_barrier_post(q.bar, st); }
#define STAGE(S, l) { const Params q = load_params(); run_stage<S>(q, l, shm); }
#if PROBE == 11
#define SYNC() xcd_barrier(bar); xcd_barrier(bar);
#else
#define SYNC() xcd_barrier(bar);
#endif
    { const Params q = load_params(); if (q.bar == nullptr) grid.sync(); }
    STAGE(8, 0)
    if (PROBE == 1) { SYNC() STAGE(8, 0) }
    SYNC()
    STAGE(0, 0)
#define DUP(n, S, l) if (PROBE == n) { SYNC() STAGE(S, l) }
#define LAYER_REST(l) DUP(2, 0, l) SYNC() STAGE(1, l) if (PROBE >= 3 && PROBE <= 5) { SYNC() STAGE(9, l) } if (PROBE == 12) { SYNC() STAGE(12, l) } SYNC() STAGE(2, l) SYNC() STAGE(10, l) if (PROBE == 8) { SYNC() STAGE(2, l) SYNC() STAGE(10, l) } \
    SYNC() STAGE(3, l) DUP(9, 3, l) SYNC() STAGE(14, l) SYNC() STAGE(4, l) SYNC() STAGE(5, l) DUP(6, 5, l) SYNC() STAGE(6, l) DUP(7, 6, l) SYNC() STAGE(7, l)
    LAYER_REST(0)
    SYNC() STAGE(0, 1)
    LAYER_REST(1)
#undef LAYER_REST
#undef SYNC
#undef STAGE
}
#else
template <int S>
__global__ void __launch_bounds__(512, 2) k_one(Params p, int l) {
    extern __shared__ __attribute__((aligned(16))) char shm[];
    run_stage<S>(p, l, shm);
}
template <int S> static void launch_one(const Params& p, int l, hipStream_t stream) {
    (void)hipFuncSetAttribute((const void*)k_one<S>, hipFuncAttributeMaxDynamicSharedMemorySize, LDS_BYTES);
    hipLaunchKernelGGL(k_one<S>, dim3(256), dim3(512), LDS_BYTES, stream, p, l);
}
#endif

extern "C" void kernel_launch(void* const* d_in, const int* in_sizes, int n_in, void* d_out, int out_size, void* d_ws, size_t ws_size, hipStream_t stream) {
    Params p{};
    const float* const* in = (const float* const*)d_in;
    p.x_prompt = in[0]; p.x_sample = in[1]; p.cache_k = in[2]; p.cache_v = in[3]; p.cache_logf = in[4]; p.state_gla = in[5]; p.g_mix_pre = in[6]; p.w_in = in[7];
    p.w_gate_up = in[8]; p.b_gate = in[9]; p.b_fox_f = in[10]; p.g_onorm = in[11]; p.w_out = in[12]; p.g_mix_post = in[13]; p.g_mlp_pre = in[14]; p.w_up = in[15];
    p.w_down = in[16]; p.g_mlp_post = in[17];
    p.out = (float*)d_out;
    char* w = (char*)d_ws; size_t off = 0;
    auto take = [&](size_t bytes) { char* r = w + off; off += (bytes + 255) & ~(size_t)255; return r; };
    p.ctr = (unsigned*)take(256);
    p.bar = (unsigned*)take((size_t)XCD_BAR_WORDS * 4);
    p.WinT = (bf16_t*)take((size_t)2 * NIN * DM * 2); p.WoutT = (bf16_t*)take((size_t)2 * DM * DM * 2);
    p.WupT = (bf16_t*)take((size_t)2 * DFF * DM * 2); p.WdownT = (bf16_t*)take((size_t)2 * DM * DFF * 2);
    p.H = (bf16_t*)take((size_t)MT * DM * 2); p.MRG = (bf16_t*)take((size_t)MT * DM * 2); p.Z = (bf16_t*)take((size_t)MT * NZ * 2);
    p.U = (bf16_t*)take((size_t)MT * DFF * 2);
    p.EX = (float*)take((size_t)MT * 32 * 4); p.RAW = (bf16_t*)take((size_t)MT * DM * 2); p.YB = (bf16_t*)take((size_t)MT * DM * 2); p.OG = (float*)take((size_t)MT * 1024 * 4); p.DEC = (float*)take((size_t)544 * 128 * 4); p.PART = (float*)take((size_t)SPLIT_DOWN * 256 * DM * 4);
    p.FSO = (float*)take((size_t)256 * 32 * 128 * 4); p.FSML = (float*)take((size_t)256 * 32 * 2 * 4);
    p.KVT = (float*)p.U; p.SS = (bf16_t*)((char*)p.U + (size_t)544 * 32768 * 4); p.QI = (bf16_t*)((char*)p.U + (size_t)544 * 32768 * 6);
    if (off > ws_size) { fprintf(stderr, "workspace too small: need %zu have %zu\n", off, ws_size); return; }
#if MEGA
    static int grid_blocks = 0;
    if (!grid_blocks) {
        (void)hipFuncSetAttribute((const void*)k_mega, hipFuncAttributeMaxDynamicSharedMemorySize, LDS_BYTES);
        int dev = 0, cus = 0, per_cu = 0; hipGetDevice(&dev); hipDeviceGetAttribute(&cus, hipDeviceAttributeMultiprocessorCount, dev);
        hipOccupancyMaxActiveBlocksPerMultiprocessor(&per_cu, k_mega, 512, LDS_BYTES);
        if (per_cu < 1) per_cu = 1;
        grid_blocks = cus;
    }
    (void)hipMemsetAsync(p.bar, 0, (size_t)XCD_BAR_WORDS * 4, stream);
    void* args[] = {&p};
    hipError_t e = hipLaunchCooperativeKernel((void*)k_mega, dim3(grid_blocks), dim3(512), args, LDS_BYTES, stream);
    if (e != hipSuccess) fprintf(stderr, "cooperative launch failed: %s (grid %d)\n", hipGetErrorString(e), grid_blocks);
#else
    launch_one<8>(p, 0, stream);
    for (int l = 0; l < 2; ++l) { launch_one<0>(p, l, stream); launch_one<1>(p, l, stream); launch_one<2>(p, l, stream); launch_one<10>(p, l, stream); launch_one<3>(p, l, stream);
        launch_one<14>(p, l, stream); launch_one<4>(p, l, stream); launch_one<5>(p, l, stream); launch_one<6>(p, l, stream); launch_one<7>(p, l, stream); }
#endif
}
```

```cpp
#include <hip/hip_runtime.h>
#include <hip/hip_cooperative_groups.h>
#include <cstdio>
namespace cg = cooperative_groups;
#ifndef MEGA
#define MEGA 1
#endif
#ifndef PROBE
#define PROBE 0
#endif
__device__ __forceinline__ int tid_opaque() { int t = threadIdx.x; asm volatile("" : "+v"(t)); return t; }
#define XB_TMO      128
#define XB_XCNT(j)  (256  + 64 * (j))
#define XB_XSUB(j)  (1280 + 64 * (j))
#define XB_XGEN(j)  (2304 + 64 * (j))
#define XB_TOP      3328
#define XB_TOPGEN   3392
#define XCD_BAR_WORDS 3456
#define XB_SPIN_CAP (1u << 18)
#define LAS __attribute__((address_space(3)))

__device__ __forceinline__ unsigned xb_ld(unsigned* p)              { return __hip_atomic_load(p, __ATOMIC_RELAXED, __HIP_MEMORY_SCOPE_AGENT); }
__device__ __forceinline__ unsigned xb_add(unsigned* p, unsigned v) { return __hip_atomic_fetch_add(p, v, __ATOMIC_RELAXED, __HIP_MEMORY_SCOPE_AGENT); }
__device__ __forceinline__ unsigned xb_xcc_id() { return (unsigned)__builtin_amdgcn_s_getreg((3 << 11) | 20) & 0xFu; }
#define XB_SPIN(cond, bar) do { unsigned _sp = 0; while (cond) { __builtin_amdgcn_s_sleep(1); \
    if ((++_sp & 255u) == 0u) { if (xb_ld(&(bar)[XB_TMO])) break; if (_sp > XB_SPIN_CAP) { atomicAdd(&(bar)[XB_TMO], 1u); break; } } } } while (0)

struct XcdBarrier {
    unsigned* bar; unsigned x;
    volatile LAS unsigned* st;
};

__device__ __forceinline__ XcdBarrier xcd_barrier_post(unsigned* bar, volatile LAS unsigned* st) {
    XcdBarrier b; b.bar = bar; b.x = xb_xcc_id(); b.st = st;
    if (threadIdx.x == 0) (void)xb_add(&bar[XB_XCNT(b.x)], 1u);
    return b;
}
__device__ __forceinline__ void xcd_barrier_complete(unsigned* bar, unsigned x, unsigned& nloc, unsigned& nx) {
    const unsigned G = gridDim.x * gridDim.y * gridDim.z;
    unsigned sum, cnt, mine, sp = 0u;
    for (;;) {
        sum = 0u; cnt = 0u; mine = 0u;
#pragma unroll
        for (unsigned j = 0; j < 16; ++j) { const unsigned c = xb_ld(&bar[XB_XCNT(j)]); sum += c; cnt += (c > 0u) ? 1u : 0u; mine = (j == x) ? c : mine; }
        if (sum == G) break;
        __builtin_amdgcn_s_sleep(1);
        if ((++sp & 255u) == 0u) { if (xb_ld(&bar[XB_TMO])) break; if (sp > XB_SPIN_CAP) { atomicAdd(&bar[XB_TMO], 1u); break; } }
    }
    nloc = mine > 0u ? mine : 1u; nx = cnt > 0u ? cnt : 1u;
}

__device__ __forceinline__ void xcd_barrier(const XcdBarrier& b) {
    asm volatile("s_waitcnt vmcnt(0)" ::: "memory");
    __syncthreads();
    if (threadIdx.x == 0) {
        unsigned* bar = b.bar;
        __builtin_amdgcn_s_waitcnt(0);
        unsigned nloc = b.st[0], nx = b.st[1];
        if (nloc == 0u) { xcd_barrier_complete(bar, b.x, nloc, nx); b.st[0] = nloc; b.st[1] = nx; }
        const unsigned old = xb_add(&bar[XB_XSUB(b.x)], 1u);
        const unsigned gen = old / nloc;
        if (old + 1u == (gen + 1u) * nloc) {
            __builtin_amdgcn_fence(__ATOMIC_RELEASE, "agent");
            asm volatile("s_waitcnt vmcnt(0)" ::: "memory");
            const unsigned og = xb_add(&bar[XB_TOP], 1u);
            const unsigned tg = og / nx;
            if (og + 1u == (tg + 1u) * nx) xb_add(&bar[XB_TOPGEN], 1u);
            else XB_SPIN(xb_ld(&bar[XB_TOPGEN]) == tg, bar);
            __builtin_amdgcn_fence(__ATOMIC_ACQUIRE, "agent");
            xb_add(&bar[XB_XGEN(b.x)], 1u);
            asm volatile("s_waitcnt vmcnt(0)" ::: "memory");
        } else {
            XB_SPIN(xb_ld(&bar[XB_XGEN(b.x)]) == gen, bar);
            __builtin_amdgcn_fence(__ATOMIC_ACQUIRE, "agent");
            asm volatile("s_waitcnt vmcnt(0)" ::: "memory");
        }
    }
    __syncthreads();
}
namespace pg8 {
#define PG8_LAS __attribute__((address_space(3)))
typedef unsigned short bf16_t;
typedef short bf16x8 __attribute__((ext_vector_type(8)));
typedef float f32x4 __attribute__((ext_vector_type(4)));
typedef unsigned u32x4 __attribute__((ext_vector_type(4)));
constexpr int BM = 256, BK = 64, HALF = 128, HTB = HALF * BK * 2  , STAGE_BYTES = 8 * HTB, NXCD = 8, WGM = 8;

__host__ __device__ __forceinline__ int lds_byte(int r, int c) { const int st = (r >> 4) * 2 + (c >> 5), rr = r & 15, cc = c & 31, ob = rr * 64 + cc * 2; return st * 1024 + (ob ^ (((ob >> 9) & 1) << 5)); }
__host__ __device__ __forceinline__ void stage_rc(int b, int& R, int& C) { const int st = b / 1024, sb = b % 1024, swz = sb ^ (((sb >> 9) & 1) << 5); R = (st >> 1) * 16 + swz / 64; C = (st & 1) * 32 + (swz % 64) / 2; }
__host__ __device__ __forceinline__ int perm32(int rho) { const int n = rho >> 4, i = rho & 15; return 8 * (i >> 2) + 4 * n + (i & 3); }

struct Unit { int pm, pn; };
struct Gemm { const bf16_t* A; const bf16_t* Bt; int M, N, K; int lda, ldb, nct, ksub; };

struct StaticOrder {
    int nM, nN, nwg, G, c;
    __host__ __device__ void init(int M, int N, int G_, int c_) { nM = M / BM; nN = N / BM; nwg = nM * nN; G = G_; c = c_; }
    __host__ __device__ bool next(int i, Unit& u) const {
        const long L = (long)i * G + c; if (L >= nwg) return false;
        int wgid = (int)L; { const int q = nwg / NXCD, r = nwg % NXCD, xcd = wgid % NXCD, off = wgid / NXCD; wgid = (xcd < r ? xcd * (q + 1) : r * (q + 1) + (xcd - r) * q) + off; }
        const int nig = WGM * nN, gid = wgid / nig, fm = gid * WGM, gsz = (nM - fm) < WGM ? (nM - fm) : WGM;
        u.pm = fm + ((wgid % nig) % gsz); u.pn = (wgid % nig) / gsz; return true;
    }
    __device__ __forceinline__ void a_ready(const Unit&) const {}
    __device__ __forceinline__ void done(const Unit&) const {}
};

template <class Epi, class Sched, bool STAMP = false>
__device__ __forceinline__ void gemm_phase(PG8_LAS unsigned char* lds, const Gemm g, const Sched& S, const Epi& E, unsigned long long* stamps) {
    const int tid = tid_opaque(), wid = __builtin_amdgcn_readfirstlane(tid >> 6), lane = tid & 63, wr = wid >> 2, wc = wid & 3, fr = lane & 15, fq = lane >> 4;
    const int K = g.K, nt = K / BK;
    int ts_lo = 0, ts_hi = 0, nts = 0; const unsigned long long rt_entry = STAMP ? (unsigned long long)wall_clock64() : 0ull;
#define PG8_STAMP() do { if (STAMP && wid == 0 && nts < 64) { const unsigned long long _c = (unsigned long long)clock64(); \
        ts_lo = (lane == nts) ? (int)(unsigned)_c : ts_lo; ts_hi = (lane == nts) ? (int)(unsigned)(_c >> 32) : ts_hi; ++nts; } } while (0)
    PG8_STAMP();
    unsigned voffA[2], voffB[2];
#pragma unroll
    for (int i = 0; i < 2; ++i) { int R, C; stage_rc(tid * 16 + i * 8192, R, C); const int Rb = Epi::PERM ? ((R & ~31) + perm32(R & 31)) : R;
        voffA[i] = (unsigned)(R * g.lda + C) * 2u; voffB[i] = (unsigned)(Rb * g.ldb + C) * 2u; }
    const size_t kstep = (size_t)(BK * 2);
    const size_t hstepA = (size_t)HALF * g.lda * 2, hstepB = (size_t)HALF * g.ldb * 2;
    const size_t tstepA = 2 * hstepA, tstepB = 2 * hstepB;
    const unsigned ldsw = (unsigned)wid * 1024u;
    const int aoff = lds_byte(wr * 64 + fr, fq * 8), boff = lds_byte(wc * 32 + fr, fq * 8);
#define PG8_SA(b, h) (((b) * 2 + (h)) * HTB)
#define PG8_SB(b, h) ((4 + (b) * 2 + (h)) * HTB)
#define PG8_STAGE(bufoff, gbase, voff) do { _Pragma("unroll") for (int _i = 0; _i < 2; ++_i) \
        __builtin_amdgcn_global_load_lds((const unsigned*)((const char*)(gbase) + (voff)[_i]), (PG8_LAS unsigned*)(lds + (bufoff) + ldsw + _i * 8192), 16, 0, 0); } while (0)
#define PG8_LDA(dst, b, h) do { _Pragma("unroll") for (int m = 0; m < 4; ++m) _Pragma("unroll") for (int k = 0; k < 2; ++k) dst[m][k] = *(const PG8_LAS bf16x8*)(lds + PG8_SA(b, h) + aoff + m * 2048 + k * 1024); } while (0)
#define PG8_LDB(dst, b, h) do { _Pragma("unroll") for (int n = 0; n < 2; ++n) _Pragma("unroll") for (int k = 0; k < 2; ++k) dst[n][k] = *(const PG8_LAS bf16x8*)(lds + PG8_SB(b, h) + boff + n * 2048 + k * 1024); } while (0)
#define PG8_MMA(ai, bj, At, Bt) do { __builtin_amdgcn_s_setprio(1); _Pragma("unroll") for (int m = 0; m < 4; ++m) _Pragma("unroll") for (int n = 0; n < 2; ++n) _Pragma("unroll") for (int k = 0; k < 2; ++k) \
        acc[ai][bj][m][n] = __builtin_amdgcn_mfma_f32_16x16x32_bf16(Bt[n][k], At[m][k], acc[ai][bj][m][n], 0, 0, 0); __builtin_amdgcn_s_setprio(0); } while (0)
#define PG8_WAIT_V(n) asm volatile("s_waitcnt vmcnt(" #n ")" ::: "memory")
#define PG8_WAIT_L(n) asm volatile("s_waitcnt lgkmcnt(" #n ")" ::: "memory")
#define PG8_BAR __builtin_amdgcn_s_barrier()
#define PG8_SCHED __builtin_amdgcn_sched_barrier(0)
    Unit cur, nxt; int ui = 0;
    if (!S.next(0, cur)) return;
    f32x4 acc[2][2][4][2];
#pragma unroll
    for (int a = 0; a < 2; ++a)
#pragma unroll
        for (int b = 0; b < 2; ++b)
#pragma unroll
            for (int m = 0; m < 4; ++m)
#pragma unroll
                for (int n = 0; n < 2; ++n) acc[a][b][m][n] = (f32x4){0.f, 0.f, 0.f, 0.f};
    bf16x8 At[4][2], B0[2][2], B1[2][2];
    const char* cA = (const char*)g.A + (size_t)cur.pm * tstepA + (size_t)(cur.pn / g.nct) * g.ksub * 2; const char* cB = (const char*)g.Bt + (size_t)(cur.pn % g.nct) * tstepB + (size_t)(cur.pn / g.nct) * g.ksub * 2;
    S.a_ready(cur);
    PG8_STAGE(PG8_SB(0, 0), cB, voffB); PG8_STAGE(PG8_SA(0, 0), cA, voffA); PG8_STAGE(PG8_SB(0, 1), cB + hstepB, voffB); PG8_STAGE(PG8_SA(0, 1), cA + hstepA, voffA);
    if (wr == 1) PG8_BAR;
    PG8_WAIT_V(4); PG8_BAR;
    PG8_STAGE(PG8_SB(1, 0), cB + kstep, voffB); PG8_STAGE(PG8_SA(1, 0), cA + kstep, voffA); PG8_STAGE(PG8_SB(1, 1), cB + hstepB + kstep, voffB);
    PG8_WAIT_V(6); PG8_BAR;
    PG8_STAMP();
    for (;;) {
        const bool has_next = S.next(ui + 1, nxt);
        const char* nA = has_next ? (const char*)g.A + (size_t)nxt.pm * tstepA + (size_t)(nxt.pn / g.nct) * g.ksub * 2 : cA; const char* nB = has_next ? (const char*)g.Bt + (size_t)(nxt.pn % g.nct) * tstepB + (size_t)(nxt.pn / g.nct) * g.ksub * 2 : cB;
        for (int t = 0; t < nt; t += 2) {
            const bool last = (t == nt - 2);
            const char* a1 = cA + (size_t)(t + 1) * kstep;
            const char* a2 = last ? nA : cA + (size_t)(t + 2) * kstep; const char* b2 = last ? nB : cB + (size_t)(t + 2) * kstep;
            const char* a3 = a2 + kstep; const char* b3 = b2 + kstep;
            if (last && has_next) S.a_ready(nxt);
            PG8_LDB(B0, 0, 0); PG8_SCHED; PG8_LDA(At, 0, 0); PG8_STAGE(PG8_SA(1, 1), a1 + hstepA, voffA);
            PG8_WAIT_L(8); PG8_BAR; PG8_WAIT_L(0); PG8_MMA(0, 0, At, B0); PG8_BAR; PG8_SCHED;
            PG8_LDB(B1, 0, 1); PG8_STAGE(PG8_SB(0, 0), b2, voffB);
            PG8_BAR; PG8_WAIT_L(0); PG8_MMA(0, 1, At, B1); PG8_BAR;
            PG8_LDA(At, 0, 1); PG8_STAGE(PG8_SA(0, 0), a2, voffA);
            PG8_BAR; PG8_WAIT_L(0); PG8_MMA(1, 0, At, B0); PG8_BAR; PG8_SCHED;
            PG8_STAGE(PG8_SB(0, 1), b2 + hstepB, voffB);
            PG8_WAIT_V(6); PG8_BAR; PG8_MMA(1, 1, At, B1); PG8_BAR;
            PG8_LDB(B0, 1, 0); PG8_SCHED; PG8_LDA(At, 1, 0); PG8_STAGE(PG8_SA(0, 1), a2 + hstepA, voffA);
            PG8_WAIT_L(8); PG8_BAR; PG8_WAIT_L(0); PG8_MMA(0, 0, At, B0); PG8_BAR; PG8_SCHED;
            PG8_LDB(B1, 1, 1); PG8_STAGE(PG8_SB(1, 0), b3, voffB);
            PG8_BAR; PG8_WAIT_L(0); PG8_MMA(0, 1, At, B1); PG8_BAR;
            PG8_LDA(At, 1, 1); PG8_STAGE(PG8_SA(1, 0), a3, voffA);
            PG8_BAR; PG8_WAIT_L(0); PG8_MMA(1, 0, At, B0); PG8_BAR; PG8_SCHED;
            PG8_STAGE(PG8_SB(1, 1), b3 + hstepB, voffB);
            PG8_WAIT_V(6); PG8_BAR; PG8_MMA(1, 1, At, B1); PG8_BAR;
        }
        PG8_STAMP();
        if constexpr (!Epi::AFTER_DRAIN) { E(acc, cur, wr, wc, fr, fq); S.done(cur); }
        PG8_STAMP();
        if (!has_next) break;
#pragma unroll
        for (int a = 0; a < 2; ++a)
#pragma unroll
            for (int b = 0; b < 2; ++b)
#pragma unroll
                for (int m = 0; m < 4; ++m)
#pragma unroll
                    for (int n = 0; n < 2; ++n) acc[a][b][m][n] = (f32x4){0.f, 0.f, 0.f, 0.f};
        cur = nxt; cA = nA; cB = nB; ++ui;
    }
    PG8_WAIT_V(0);
    if (wr == 0) PG8_BAR;
    PG8_BAR;
    if constexpr (Epi::AFTER_DRAIN) { E.fused(acc, cur, wr, wc, fr, fq, lds, wid, lane); S.done(cur); }
    PG8_STAMP();
    if (STAMP && wid == 0) { stamps[lane] = lane < nts ? (((unsigned long long)(unsigned)ts_hi << 32) | (unsigned)ts_lo) : 0ull;
        if (lane == 62) stamps[62] = rt_entry; if (lane == 63) stamps[63] = (unsigned long long)wall_clock64(); }
#undef PG8_STAMP
#undef PG8_SA
#undef PG8_SB
#undef PG8_STAGE
#undef PG8_LDA
#undef PG8_LDB
#undef PG8_MMA
#undef PG8_WAIT_V
#undef PG8_WAIT_L
#undef PG8_BAR
#undef PG8_SCHED
}
}

using pg8::bf16_t; using pg8::bf16x8; using pg8::f32x4; using pg8::u32x4;
typedef short s16x4 __attribute__((ext_vector_type(4)));
typedef float f32x16 __attribute__((ext_vector_type(16)));
typedef unsigned u32x2 __attribute__((ext_vector_type(2)));
#define DI __device__ __forceinline__
#define MFMA32(a, b, c) __builtin_amdgcn_mfma_f32_32x32x16_bf16((a), (b), (c), 0, 0, 0)

constexpr int NP = 8192, NS = 256, MT = 8448, DM = 2048, NZ = 6144, NIN = 6400, DFF = 8192;
constexpr float EPS = 1e-6f, LOG2E = 1.4426950408889634f;
constexpr int LDS_BYTES = 154112;
constexpr int LDS_ITEM_OFF = 153792;
constexpr size_t O_YP = 0, O_YS = 16777216, O_KP = 17301504, O_VP = 34078720, O_LFP = 50855936, O_STP = 50987008,
                 O_KS = 52035584, O_VS = 52559872, O_LFS = 53084160, O_STS = 53088256;

struct Params {
    const float *x_prompt, *x_sample, *cache_k, *cache_v, *cache_logf, *state_gla, *g_mix_pre, *w_in, *w_gate_up, *b_gate, *b_fox_f,
                *g_onorm, *w_out, *g_mix_post, *g_mlp_pre, *w_up, *w_down, *g_mlp_post;
    float* out;
    bf16_t *WinT, *WoutT, *WupT, *WdownT, *H, *MRG, *Z, *U;
    bf16_t* RAW;
    bf16_t* YB;
    float *EX, *OG, *DEC, *KVT, *PART, *FSO, *FSML;
    bf16_t *SS, *QI;
    unsigned* ctr;
    unsigned* bar;
};

DI unsigned pk2(float a, float b) { typedef __bf16 v2 __attribute__((ext_vector_type(2))); v2 v; v[0] = (__bf16)a; v[1] = (__bf16)b; return __builtin_bit_cast(unsigned, v); }
DI bf16_t f2bf(float a) { return __builtin_bit_cast(unsigned short, (__bf16)a); }
DI float bf2f(unsigned u) { return __uint_as_float(u << 16); }
DI float bflo(unsigned u) { return __uint_as_float(u << 16); }
DI float bfhi(unsigned u) { return __uint_as_float(u & 0xffff0000u); }
DI float logsig(float x) { return fminf(x, 0.f) - log1pf(__expf(-fabsf(x))); }
DI int crow(int reg, int h) { return (reg & 3) + 8 * (reg >> 2) + 4 * h; }
DI float wave_sum(float v) {
#pragma unroll
    for (int o = 32; o >= 1; o >>= 1) v += __shfl_xor(v, o);
    return v;
}

struct EpiIn {
    static constexpr bool PERM = true, AFTER_DRAIN = false;
    bf16_t* Z; float* EX; float *outk_p, *outv_p, *outk_s, *outv_s; int row_base, pn_base;
    DI void operator()(const f32x4 (&acc)[2][2][4][2], const pg8::Unit& u, int wr, int wc, int fr, int fq) const {
        const int row0 = row_base + u.pm * 256 + wr * 64 + fr, pn = pn_base + u.pn;
        const float sc = pn < 2 ? 0.08838834764831845f : 1.0f;
#pragma unroll
        for (int ai = 0; ai < 2; ++ai)
#pragma unroll
            for (int m = 0; m < 4; ++m) {
                const int row = row0 + ai * 128 + m * 16;
#pragma unroll
                for (int bj = 0; bj < 2; ++bj) {
                    const int cc = bj * 128 + wc * 32 + 8 * fq;
                    const f32x4 v0 = acc[ai][bj][m][0], v1 = acc[ai][bj][m][1];
                    if (pn < 24) {
                        u32x4 pk; pk[0] = pk2(v0[0] * sc, v0[1] * sc); pk[1] = pk2(v0[2] * sc, v0[3] * sc); pk[2] = pk2(v1[0] * sc, v1[1] * sc); pk[3] = pk2(v1[2] * sc, v1[3] * sc);
                        *(u32x4*)(Z + (size_t)row * NZ + pn * 256 + cc) = pk;
                        if (pn >= 16) {
                            const bool isk = pn < 20; const int gc = (pn - (isk ? 16 : 20)) * 256 + cc;
                            float* dst = row < NP ? (isk ? outk_p : outv_p) + (size_t)row * 1024 + gc : (isk ? outk_s : outv_s) + (size_t)(row - NP) * 1024 + gc;
                            *(f32x4*)dst = v0; *(f32x4*)(dst + 4) = v1;
                        }
                    } else if (cc < 24) {
                        float* ex = EX + (size_t)row * 32 + cc;
                        *(f32x4*)ex = v0; *(f32x4*)(ex + 4) = v1;
                    }
                }
            }
    }
};
struct EpiRaw {
    static constexpr bool PERM = true, AFTER_DRAIN = false;
    bf16_t* C;
    DI void operator()(const f32x4 (&acc)[2][2][4][2], const pg8::Unit& u, int wr, int wc, int fr, int fq) const {
        const int row0 = u.pm * 256 + wr * 64 + fr, col0 = u.pn * 256 + wc * 32 + 8 * fq;
#pragma unroll
        for (int ai = 0; ai < 2; ++ai)
#pragma unroll
            for (int m = 0; m < 4; ++m) {
                bf16_t* rp = C + (size_t)(row0 + ai * 128 + m * 16) * DM + col0;
#pragma unroll
                for (int bj = 0; bj < 2; ++bj) {
                    const f32x4 a = acc[ai][bj][m][0], b = acc[ai][bj][m][1];
                    u32x4 pk; pk[0] = pk2(a[0], a[1]); pk[1] = pk2(a[2], a[3]); pk[2] = pk2(b[0], b[1]); pk[3] = pk2(b[2], b[3]);
                    *(u32x4*)(rp + bj * 128) = pk;
                }
            }
    }
};
struct EpiUp {
    static constexpr bool PERM = true, AFTER_DRAIN = false;
    bf16_t* U;
    DI void operator()(const f32x4 (&acc)[2][2][4][2], const pg8::Unit& u, int wr, int wc, int fr, int fq) const {
        const int row0 = u.pm * 256 + wr * 64 + fr, col0 = u.pn * 256 + wc * 32 + 8 * fq;
#pragma unroll
        for (int ai = 0; ai < 2; ++ai)
#pragma unroll
            for (int m = 0; m < 4; ++m) {
                bf16_t* rp = U + (size_t)(row0 + ai * 128 + m * 16) * DFF + col0;
#pragma unroll
                for (int bj = 0; bj < 2; ++bj) {
                    f32x4 a = acc[ai][bj][m][0], b = acc[ai][bj][m][1];
#pragma unroll
                    for (int e = 0; e < 4; ++e) { a[e] = fmaxf(a[e], 0.f); a[e] *= a[e]; b[e] = fmaxf(b[e], 0.f); b[e] *= b[e]; }
                    u32x4 pk; pk[0] = pk2(a[0], a[1]); pk[1] = pk2(a[2], a[3]); pk[2] = pk2(b[0], b[1]); pk[3] = pk2(b[2], b[3]);
                    *(u32x4*)(rp + bj * 128) = pk;
                }
            }
    }
};

struct EpiPart {
    static constexpr bool PERM = true, AFTER_DRAIN = false;
    bf16_t* P;
    DI void operator()(const f32x4 (&acc)[2][2][4][2], const pg8::Unit& u, int wr, int wc, int fr, int fq) const {
        const int split = u.pn >> 3, ct = u.pn & 7;
        const int row0 = wr * 64 + fr, col0 = ct * 256 + wc * 32 + 8 * fq;
#pragma unroll
        for (int ai = 0; ai < 2; ++ai)
#pragma unroll
            for (int m = 0; m < 4; ++m) {
                bf16_t* rp = P + ((size_t)split * 256 + row0 + ai * 128 + m * 16) * DM + col0;
#pragma unroll
                for (int bj = 0; bj < 2; ++bj) { const f32x4 a = acc[ai][bj][m][0], b = acc[ai][bj][m][1];
                    u32x4 pk; pk[0] = pk2(a[0], a[1]); pk[1] = pk2(a[2], a[3]); pk[2] = pk2(b[0], b[1]); pk[3] = pk2(b[2], b[3]); *(u32x4*)(rp + bj * 128) = pk; }
            }
    }
};

template <class Epi>
DI void run_gemm(char* shm, const bf16_t* A, const bf16_t* Bt, int M, int N, int K, int lda, int ldb, int nsplit, const Epi& E, int G = 0, int c = 0) {
    pg8::Gemm g; g.A = A; g.Bt = Bt; g.M = M; g.N = N * nsplit; g.K = K; g.lda = lda; g.ldb = ldb; g.nct = N / 256; g.ksub = K;
    if (G == 0) { G = (int)gridDim.x; c = (int)blockIdx.x; }
    pg8::StaticOrder S; S.init(M, N * nsplit, G, c);
    pg8::gemm_phase<Epi, pg8::StaticOrder, false>((PG8_LAS unsigned char*)shm, g, S, E, nullptr);
}

DI void norm_rows(const float* xin_p, const float* xin_s, const bf16_t* raw, const float* part, int nsplit, const float* gpost, const float* gnext, float* yout_p, float* yout_s, bf16_t* H,
                  int row_lo, int row_hi, int wblk, int nwblk, bool spread = false, const bf16_t* xb = nullptr, bf16_t* yb = nullptr) {
    const int lane = tid_opaque() & 63, wid = tid_opaque() >> 6;
    f32x4 gpv[8], gnv[8];
#pragma unroll
    for (int i = 0; i < 8; ++i) {
        gpv[i] = gpost ? *(const f32x4*)(gpost + (i * 64 + lane) * 4) : (f32x4){0.f, 0.f, 0.f, 0.f};
        gnv[i] = gnext ? *(const f32x4*)(gnext + (i * 64 + lane) * 4) : (f32x4){0.f, 0.f, 0.f, 0.f};
    }
    for (int row = row_lo + (spread ? wblk + wid * nwblk : wblk * 8 + wid); row < row_hi; row += nwblk * 8) {
        f32x4 xv[8];
        if (xb) {
#pragma unroll
            for (int i = 0; i < 8; ++i) { const u32x2 b = *(const u32x2*)(xb + (size_t)row * DM + (i * 64 + lane) * 4); xv[i][0] = bflo(b[0]); xv[i][1] = bfhi(b[0]); xv[i][2] = bflo(b[1]); xv[i][3] = bfhi(b[1]); }
        } else {
            const float* xi = row < NP ? xin_p + (size_t)row * DM : xin_s + (size_t)(row - NP) * DM;
#pragma unroll
            for (int i = 0; i < 8; ++i) xv[i] = *(const f32x4*)(xi + (i * 64 + lane) * 4);
        }
        if (raw) {
            f32x4 rv[8]; float ss = 0.f;
            if (row < NP) {
#pragma unroll
                for (int i = 0; i < 8; ++i) { const u32x2 rb = *(const u32x2*)(raw + (size_t)row * DM + (i * 64 + lane) * 4); rv[i][0] = bflo(rb[0]); rv[i][1] = bfhi(rb[0]); rv[i][2] = bflo(rb[1]); rv[i][3] = bfhi(rb[1]); }
            } else {
                const bf16_t* pr = (const bf16_t*)part + (size_t)(row - NP) * DM + lane * 4;
#pragma unroll
                for (int i = 0; i < 8; ++i) { const u32x2 b = *(const u32x2*)(pr + i * 256); rv[i][0] = bflo(b[0]); rv[i][1] = bfhi(b[0]); rv[i][2] = bflo(b[1]); rv[i][3] = bfhi(b[1]); }
#pragma unroll 4
                for (int s = 1; s < nsplit; ++s) {
                    u32x2 tv[8];
#pragma unroll
                    for (int i = 0; i < 8; ++i) tv[i] = *(const u32x2*)(pr + (size_t)s * 256 * DM + i * 256);
#pragma unroll
                    for (int i = 0; i < 8; ++i) { rv[i][0] += bflo(tv[i][0]); rv[i][1] += bfhi(tv[i][0]); rv[i][2] += bflo(tv[i][1]); rv[i][3] += bfhi(tv[i][1]); }
                }
            }
#pragma unroll
            for (int i = 0; i < 8; ++i) ss += rv[i][0] * rv[i][0] + rv[i][1] * rv[i][1] + rv[i][2] * rv[i][2] + rv[i][3] * rv[i][3];
            ss = wave_sum(ss); const float rs = rsqrtf(ss * (1.0f / DM) + EPS);
#pragma unroll
            for (int i = 0; i < 8; ++i) xv[i] += rv[i] * rs * gpv[i];
            if (yb) {
#pragma unroll
                for (int i = 0; i < 8; ++i) { u32x2 pk; pk[0] = pk2(xv[i][0], xv[i][1]); pk[1] = pk2(xv[i][2], xv[i][3]); *(u32x2*)(yb + (size_t)row * DM + (i * 64 + lane) * 4) = pk; }
            } else {
                float* yo = row < NP ? yout_p + (size_t)row * DM : yout_s + (size_t)(row - NP) * DM;
#pragma unroll
                for (int i = 0; i < 8; ++i) *(f32x4*)(yo + (i * 64 + lane) * 4) = xv[i];
            }
        }
        if (gnext) {
            float ss = 0.f;
#pragma unroll
            for (int i = 0; i < 8; ++i) ss += xv[i][0] * xv[i][0] + xv[i][1] * xv[i][1] + xv[i][2] * xv[i][2] + xv[i][3] * xv[i][3];
            ss = wave_sum(ss); const float rs = rsqrtf(ss * (1.0f / DM) + EPS);
#pragma unroll
            for (int i = 0; i < 8; ++i) {
                const f32x4 hv = xv[i] * rs * gnv[i];
                u32x2 pk; pk[0] = pk2(hv[0], hv[1]); pk[1] = pk2(hv[2], hv[3]);
                *(u32x2*)(H + (size_t)row * DM + (i * 64 + lane) * 4) = pk;
            }
        }
    }
}

constexpr int RG_IN = 18;
struct InOrder {
    pg8::StaticOrder so; int G, c;
    DI void init(int G_, int c_) { so.init(MT, 21 * 256, G_, c_); G = G_; c = c_; }
    DI bool next(int i, pg8::Unit& u) const {
        const int L = i * G + c;
        if (L < 693) { so.next(i, u); if (u.pn >= 8) u.pn += 4; return true; }
        const int L2 = L - 693;
        if (L2 < RG_IN * 4) { u.pm = L2 >> 2; u.pn = 8 + (L2 & 3); return true; }
        return false;
    }
    DI void a_ready(const pg8::Unit&) const {}
    DI void done(const pg8::Unit&) const {}
};

struct ConvTile { const float* src; bf16_t* dst; int ld, Kd, k0, n0, sc; };
DI ConvTile conv_tile(const Params& p, int t, int lane) {
    ConvTile c; const int l = t >= 3104 ? 1 : 0; int u = t - l * 3104; int nn;
    if (u < 800) { c.k0 = (u / 25) * 64; c.n0 = (u % 25) * 256; c.src = p.w_in + (size_t)l * DM * 6168; c.ld = 6168; c.dst = p.WinT + (size_t)l * NIN * DM; c.Kd = DM; nn = c.n0 + 4 * lane;
        c.sc = nn < 2048 ? nn : nn < 6144 ? nn + 16 : nn < 6160 ? nn - 4096 : nn < 6168 ? nn : -1; }
    else if ((u -= 800) < 256) { c.k0 = (u >> 3) * 64; c.n0 = (u & 7) * 256; c.src = p.w_out + (size_t)l * DM * DM; c.ld = DM; c.dst = p.WoutT + (size_t)l * DM * DM; c.Kd = DM; c.sc = c.n0 + 4 * lane; }
    else if ((u -= 256) < 1024) { c.k0 = (u >> 5) * 64; c.n0 = (u & 31) * 256; c.src = p.w_up + (size_t)l * DM * DFF; c.ld = DFF; c.dst = p.WupT + (size_t)l * DFF * DM; c.Kd = DM; c.sc = c.n0 + 4 * lane; }
    else { u -= 1024; c.k0 = (u >> 3) * 64; c.n0 = (u & 7) * 256; c.src = p.w_down + (size_t)l * DFF * DM; c.ld = DM; c.dst = p.WdownT + (size_t)l * DM * DFF; c.Kd = DFF; c.sc = c.n0 + 4 * lane; }
    return c;
}
DI void convert_weights(const Params& p, char* shm, int t_begin, int t_end, int t_stride) {
    const int tid = tid_opaque(), lane = tid & 63, wv = tid >> 6;
    int t = t_begin;
    if (t >= t_end) return;
    ConvTile c = conv_tile(p, t, lane);
    f32x4 v[8];
#pragma unroll
    for (int e = 0; e < 8; ++e) { v[e][0] = v[e][1] = v[e][2] = v[e][3] = 0.f; if (c.sc >= 0) v[e] = *(const f32x4*)(c.src + (size_t)(c.k0 + 8 * wv + e) * c.ld + c.sc); }
    for (;;) {
#pragma unroll
        for (int j = 0; j < 4; ++j) {
            u32x4 pk; pk[0] = pk2(v[0][j], v[1][j]); pk[1] = pk2(v[2][j], v[3][j]); pk[2] = pk2(v[4][j], v[5][j]); pk[3] = pk2(v[6][j], v[7][j]);
            *(u32x4*)(shm + (4 * lane + j) * 144 + wv * 16) = pk;
        }
        const ConvTile cur = c;
        const int tn = t + t_stride; const bool more = tn < t_end;
        if (more) { c = conv_tile(p, tn, lane);
#pragma unroll
            for (int e = 0; e < 8; ++e) { v[e][0] = v[e][1] = v[e][2] = v[e][3] = 0.f; if (c.sc >= 0) v[e] = *(const f32x4*)(c.src + (size_t)(c.k0 + 8 * wv + e) * c.ld + c.sc); } }
        __syncthreads();
#pragma unroll
        for (int i = 0; i < 4; ++i) {
            const int q = tid + 512 * i, row = q >> 3, ch = q & 7;
            *(u32x4*)(cur.dst + (size_t)(cur.n0 + row) * cur.Kd + cur.k0 + ch * 8) = *(const u32x4*)(shm + row * 144 + ch * 16);
        }
        __syncthreads();
        if (!more) break;
        t = tn;
    }
}

DI void phase0(const Params& p, char* shm) {
    if (blockIdx.x == 0 && tid_opaque() < 32) p.ctr[tid_opaque()] = 0u;
    convert_weights(p, shm, (int)blockIdx.x, 6208, (int)gridDim.x);
    norm_rows(p.x_prompt, p.x_sample, nullptr, nullptr, 0, nullptr, p.g_mix_pre, nullptr, nullptr, p.H, 0, MT, (int)blockIdx.x, (int)gridDim.x);
}

template <class F>
DI void block_cumsum(int n, F load, float* cs, float* wt) {
    const int tid = tid_opaque(), lane = tid & 63, wid = tid >> 6;
    float v[5]; float s = 0.f;
#pragma unroll
    for (int j = 0; j < 5; ++j) { const int idx = tid * 5 + j; v[j] = idx < n ? load(idx) : 0.f; s += v[j]; }
    float inc = s;
#pragma unroll
    for (int o = 1; o < 64; o <<= 1) { const float t = __shfl_up(inc, o); if (lane >= o) inc += t; }
    if (lane == 63) wt[wid] = inc;
    __syncthreads();
    float run = inc - s;
    for (int w = 0; w < wid; ++w) run += wt[w];
#pragma unroll
    for (int j = 0; j < 5; ++j) { const int idx = tid * 5 + j; run += v[j]; if (idx < n) cs[idx] = run * LOG2E; }
    __syncthreads();
}

template <int NKT>
DI void fox_tile(const bf16_t* Ks, int ldk, const bf16_t* Vt, int ldv, const float* csl, int kpos0, int qpos, float cql,
                 const bf16x8 (&qf)[8], f32x16 (&o)[4], float& m, float& l, int r, int hh, bool need_mask) {
    constexpr float SC2 = 0.08838834764831845f * LOG2E;
    f32x16 x[NKT];
#pragma unroll
    for (int t2 = 0; t2 < NKT; ++t2) {
#pragma unroll
        for (int i = 0; i < 16; ++i) x[t2][i] = 0.f;
#pragma unroll
        for (int ks = 0; ks < 8; ++ks) { const bf16x8 a = *(const bf16x8*)(Ks + (t2 * 32 + r) * ldk + 16 * ks + 8 * hh); x[t2] = MFMA32(a, qf[ks], x[t2]); }
    }
    float mx = -1e30f;
#pragma unroll
    for (int t2 = 0; t2 < NKT; ++t2)
#pragma unroll
        for (int i = 0; i < 16; ++i) {
            const int kl = t2 * 32 + crow(i, hh);
            const f32x4 c4 = *(const f32x4*)(csl + t2 * 32 + 8 * (i >> 2) + 4 * hh);
            float v = fmaf(x[t2][i], SC2, cql - c4[i & 3]);
            if (need_mask) v = (kpos0 + kl <= qpos) ? v : -1e30f;
            x[t2][i] = v; mx = fmaxf(mx, v);
        }
    mx = fmaxf(mx, __shfl_xor(mx, 32));
    const float mn = fmaxf(m, mx), alpha = __builtin_amdgcn_exp2f(m - mn);
    m = mn;
    float ls = 0.f;
#pragma unroll
    for (int t2 = 0; t2 < NKT; ++t2)
#pragma unroll
        for (int i = 0; i < 16; ++i) { const float pv = __builtin_amdgcn_exp2f(x[t2][i] - mn); x[t2][i] = pv; ls += pv; }
    l = l * alpha + ls;
    if (__builtin_amdgcn_ballot_w64(alpha != 1.0f) != 0ull) {
#pragma unroll
        for (int dt = 0; dt < 4; ++dt)
#pragma unroll
            for (int i = 0; i < 16; ++i) o[dt][i] *= alpha;
    }
#pragma unroll
    for (int t2 = 0; t2 < NKT; ++t2)
#pragma unroll
        for (int s = 0; s < 2; ++s) {
            u32x4 pp; pp[0] = pk2(x[t2][8 * s + 0], x[t2][8 * s + 1]); pp[1] = pk2(x[t2][8 * s + 2], x[t2][8 * s + 3]);
            pp[2] = pk2(x[t2][8 * s + 4], x[t2][8 * s + 5]); pp[3] = pk2(x[t2][8 * s + 6], x[t2][8 * s + 7]);
            const bf16x8 pf = __builtin_bit_cast(bf16x8, pp);
#pragma unroll
            for (int dt = 0; dt < 4; ++dt) {
                const bf16_t* vp = Vt + (dt * 32 + r) * ldv + t2 * 32 + 16 * s + 4 * hh;
                const s16x4 lo = *(const s16x4*)vp, hi = *(const s16x4*)(vp + 8);
                const bf16x8 a = __builtin_shufflevector(lo, hi, 0, 1, 2, 3, 4, 5, 6, 7);
                o[dt] = MFMA32(a, pf, o[dt]);
            }
        }
}

DI void fox_prompt_item(const Params& p, int l, int b, int h, int qb, char* shm) {
    bf16_t* Ks = (bf16_t*)shm; bf16_t* Vt = (bf16_t*)(shm + 17408); float* cs = (float*)(shm + 143360); float* wt = (float*)(shm + 151680);
    const int tid = tid_opaque(), wid = tid >> 6, lane = tid & 63, r = lane & 31, hh = lane >> 5;
    const int nkeys = (qb + 1) * 256;
    const float* lf = p.EX + ((size_t)b * 2048) * 32 + 16 + h; const float fb = p.b_fox_f[l * 8 + h];
    block_cumsum(nkeys, [&](int i) { return logsig(lf[(size_t)i * 32] + fb); }, cs, wt);
    const int qpos = qb * 256 + wid * 32 + r; const size_t qrow = (size_t)b * 2048 + qpos;
    bf16x8 qf[8];
    { const bf16_t* zq = p.Z + qrow * NZ + 3072 + h * 128;
#pragma unroll
      for (int ks = 0; ks < 8; ++ks) qf[ks] = *(const bf16x8*)(zq + 16 * ks + 8 * hh); }
    const float cql = cs[qpos];
    f32x16 o[4];
#pragma unroll
    for (int dt = 0; dt < 4; ++dt)
#pragma unroll
        for (int i = 0; i < 16; ++i) o[dt][i] = 0.f;
    float m = -1e30f, lsum = 0.f;
    const int nt = (qb + 1) * 4;
    const bf16_t* zk = p.Z + (size_t)b * 2048 * NZ + 4096 + h * 128; const bf16_t* zv = zk + 1024;
    int krow_[2], kc8[2], vrow[2], vc8[2];
#pragma unroll
    for (int i = 0; i < 2; ++i) { const int q = tid + 512 * i; krow_[i] = q >> 4; kc8[i] = (q & 15) * 8; const int wv = q >> 6, ln = q & 63; vrow[i] = (wv & 3) * 16 + (ln & 15); vc8[i] = ((wv >> 2) * 4 + (ln >> 4)) * 8; }
    u32x4 kreg[2], vreg[2];
#pragma unroll
    for (int i = 0; i < 2; ++i) { kreg[i] = *(const u32x4*)(zk + (size_t)((nt - 1) * 64 + krow_[i]) * NZ + kc8[i]); vreg[i] = *(const u32x4*)(zv + (size_t)((nt - 1) * 64 + vrow[i]) * NZ + vc8[i]); }
    const int qmaxw = qb * 256 + wid * 32 + 31, qminw = qb * 256 + wid * 32;
    for (int kt = nt - 1; kt >= 0; --kt) {
        __syncthreads();
#pragma unroll
        for (int i = 0; i < 2; ++i) {
            *(u32x4*)(Ks + krow_[i] * 136 + kc8[i]) = kreg[i];
#pragma unroll
            for (int e = 0; e < 4; ++e) { const unsigned w = vreg[i][e]; Vt[(vc8[i] + 2 * e) * 68 + vrow[i]] = (bf16_t)(w & 0xffffu); Vt[(vc8[i] + 2 * e + 1) * 68 + vrow[i]] = (bf16_t)(w >> 16); }
        }
        __syncthreads();
        if (kt > 0) {
#pragma unroll
            for (int i = 0; i < 2; ++i) { kreg[i] = *(const u32x4*)(zk + (size_t)((kt - 1) * 64 + krow_[i]) * NZ + kc8[i]); vreg[i] = *(const u32x4*)(zv + (size_t)((kt - 1) * 64 + vrow[i]) * NZ + vc8[i]); }
        }
        if (kt * 64 <= qmaxw) fox_tile<2>(Ks, 136, Vt, 68, cs + kt * 64, kt * 64, qpos, cql, qf, o, m, lsum, r, hh, kt * 64 + 63 > qminw);
    }
    const float lt = lsum + __shfl_xor(lsum, 32); const float inv = 1.0f / lt;
    bf16_t* mo = p.MRG + qrow * DM + 1024 + h * 128;
#pragma unroll
    for (int dt = 0; dt < 4; ++dt)
#pragma unroll
        for (int g = 0; g < 4; ++g) {
            u32x2 pk; pk[0] = pk2(o[dt][4 * g] * inv, o[dt][4 * g + 1] * inv); pk[1] = pk2(o[dt][4 * g + 2] * inv, o[dt][4 * g + 3] * inv);
            *(u32x2*)(mo + dt * 32 + 8 * g + 4 * hh) = pk;
        }
}

DI float logsig_fast(float x) { return fminf(x, 0.f) - 0.6931471805599453f * __builtin_amdgcn_logf(1.0f + __builtin_amdgcn_exp2f(-fabsf(x) * LOG2E)); }
DI float exp_fast(float x) { return __builtin_amdgcn_exp2f(x * LOG2E); }

DI void gla_a_item(const Params& p, int l, int it, char* shm) {
    bf16_t* Qi = (bf16_t*)shm; bf16_t* Ki = (bf16_t*)(shm + 17408); bf16_t* Ket = (bf16_t*)(shm + 34816); bf16_t* At = (bf16_t*)(shm + 53248);
    float* dec = (float*)(shm + 62464); float* tot = (float*)(shm + 62976); bf16_t* Vt = (bf16_t*)(shm + 65024);
    float* glr = (float*)(shm + 101888); bf16_t* Qraw = (bf16_t*)(shm + 105984); bf16_t* Kraw = (bf16_t*)(shm + 122368);
    const int tid = tid_opaque(), wid = tid >> 6, lane = tid & 63, r = lane & 31, hh = lane >> 5;
    const int grp = it >= 512 ? 1 : 0;
    const int h = grp ? (it & 3) : ((it >> 5) & 3);
    const int nvalid = grp ? 32 : 64;
    const size_t rowc = grp ? (size_t)NP + (size_t)((it - 512) >> 2) * 32 : (size_t)(it >> 7) * 2048 + (size_t)(it & 31) * 64;
    const int d = tid & 127, sg = tid >> 7;
    float w2[16];
#pragma unroll
    for (int k = 0; k < 16; ++k) w2[k] = p.w_gate_up[((size_t)l * 16 + k) * 512 + h * 128 + d];
    const float bias = p.b_gate[(size_t)l * 512 + h * 128 + d];
    if (tid < 256) {
        const int s = tid >> 2, part = tid & 3; f32x4 v; v[0] = v[1] = v[2] = v[3] = 0.f;
        if (s < nvalid) v = *(const f32x4*)(p.EX + (rowc + s) * 32 + part * 4);
        *(f32x4*)(glr + s * 16 + part * 4) = v;
    }
#pragma unroll
    for (int i = 0; i < 2; ++i) {
        const int q = tid + 512 * i, row = q >> 4, c8 = (q & 15) * 8;
        u32x4 qv, kv; qv[0] = qv[1] = qv[2] = qv[3] = 0u; kv = qv;
        if (row < nvalid) { const bf16_t* zr = p.Z + (rowc + row) * NZ + h * 128 + c8; qv = *(const u32x4*)zr; kv = *(const u32x4*)(zr + 512); }
        *(u32x4*)(Qraw + row * 128 + c8) = qv; *(u32x4*)(Kraw + row * 128 + c8) = kv;
    }
    __syncthreads();
    float gv[16]; float cum = 0.f;
#pragma unroll
    for (int i = 0; i < 16; ++i) {
        const int s = sg * 16 + i; float gl = 0.f;
        if (s < nvalid) {
            const float* e = glr + s * 16; float x = bias;
#pragma unroll
            for (int k4 = 0; k4 < 4; ++k4) { const f32x4 ev = *(const f32x4*)(e + 4 * k4); x += ev[0] * w2[4 * k4] + ev[1] * w2[4 * k4 + 1] + ev[2] * w2[4 * k4 + 2] + ev[3] * w2[4 * k4 + 3]; }
            gl = logsig_fast(x) * 0.0625f;
        }
        cum += gl; gv[i] = cum;
    }
    tot[sg * 128 + d] = cum;
#pragma unroll
    for (int i = 0; i < 2; ++i) {
        const int q = tid + 512 * i, wv = q >> 6, ln = q & 63, pr = (wv & 1) * 16 + (ln & 15), pc = (wv >> 1) * 4 + (ln >> 4);
        u32x4 va, vb; va[0] = va[1] = va[2] = va[3] = 0u; vb = va;
        if (2 * pr < nvalid) { const bf16_t* zr = p.Z + (rowc + 2 * pr) * NZ + 1024 + h * 256 + pc * 8; va = *(const u32x4*)zr; vb = *(const u32x4*)(zr + NZ); }
        unsigned* vd = (unsigned*)Vt;
#pragma unroll
        for (int e = 0; e < 4; ++e) {
            vd[((pc * 8 + 2 * e) * 72 + 2 * pr) >> 1] = (va[e] & 0xffffu) | (vb[e] << 16);
            vd[((pc * 8 + 2 * e + 1) * 72 + 2 * pr) >> 1] = (va[e] >> 16) | (vb[e] & 0xffff0000u);
        }
    }
    __syncthreads();
    float off = 0.f;
    for (int g = 0; g < sg; ++g) off += tot[g * 128 + d];
    const float blast = tot[d] + tot[128 + d] + tot[256 + d] + tot[384 + d];
    {
        float kev[16];
#pragma unroll
        for (int i = 0; i < 16; ++i) {
            const int s = sg * 16 + i; const float bb = off + gv[i]; float q = 0.f, k = 0.f;
            q = bf2f(Qraw[s * 128 + d]); k = bf2f(Kraw[s * 128 + d]);
            const bf16_t qi = f2bf(q * exp_fast(bb));
            Qi[s * 136 + d] = qi; Ki[s * 136 + d] = f2bf(k * exp_fast(-bb)); kev[i] = k * exp_fast(blast - bb);
        }
        u32x4 p0, p1;
        p0[0] = pk2(kev[0], kev[1]); p0[1] = pk2(kev[2], kev[3]); p0[2] = pk2(kev[4], kev[5]); p0[3] = pk2(kev[6], kev[7]);
        p1[0] = pk2(kev[8], kev[9]); p1[1] = pk2(kev[10], kev[11]); p1[2] = pk2(kev[12], kev[13]); p1[3] = pk2(kev[14], kev[15]);
        *(u32x4*)(Ket + d * 72 + sg * 16) = p0; *(u32x4*)(Ket + d * 72 + sg * 16 + 8) = p1;
        if (sg == 0) p.DEC[(size_t)it * 128 + d] = exp_fast(blast);
    }
    __syncthreads();
#pragma unroll
    for (int i = 0; i < 2; ++i) {
        const int q = tid + 512 * i, row = q >> 4, c8 = (q & 15) * 8;
        if (row < nvalid) *(u32x4*)(p.QI + (rowc + row) * 512 + h * 128 + c8) = *(const u32x4*)(Qi + row * 136 + c8);
    }
    if (wid < 3) {
        const int si = wid == 2 ? 1 : 0, ci = wid >= 1 ? 1 : 0;
        f32x16 x;
#pragma unroll
        for (int i = 0; i < 16; ++i) x[i] = 0.f;
#pragma unroll
        for (int ks = 0; ks < 8; ++ks) {
            const bf16x8 a = *(const bf16x8*)(Ki + (si * 32 + r) * 136 + 16 * ks + 8 * hh);
            const bf16x8 bq = *(const bf16x8*)(Qi + (ci * 32 + r) * 136 + 16 * ks + 8 * hh);
            x = MFMA32(a, bq, x);
        }
        const int c = ci * 32 + r;
#pragma unroll
        for (int g = 0; g < 4; ++g) {
            float v[4];
#pragma unroll
            for (int e = 0; e < 4; ++e) { const int s = si * 32 + 8 * g + 4 * hh + e; v[e] = s <= c ? x[4 * g + e] : 0.f; }
            u32x2 pk; pk[0] = pk2(v[0], v[1]); pk[1] = pk2(v[2], v[3]);
            *(u32x2*)(At + c * 72 + si * 32 + 8 * g + 4 * hh) = pk;
        }
    }
    __syncthreads();
    {
        bf16x8 av[4];
#pragma unroll
        for (int ks = 0; ks < 4; ++ks) av[ks] = *(const bf16x8*)(Vt + (wid * 32 + r) * 72 + 16 * ks + 8 * hh);
#pragma unroll
        for (int ci = 0; ci < 2; ++ci) {
            if (ci * 32 < nvalid) {
                f32x16 oa;
#pragma unroll
                for (int i = 0; i < 16; ++i) oa[i] = 0.f;
#pragma unroll
                for (int ks = 0; ks < 4; ++ks) {
                    if (ks < (ci ? 4 : 2)) { const bf16x8 bq = *(const bf16x8*)(At + (ci * 32 + r) * 72 + 16 * ks + 8 * hh); oa = MFMA32(av[ks], bq, oa); }
                }
                bf16_t* og = (bf16_t*)p.OG + (rowc + ci * 32 + r) * 1024 + h * 256 + wid * 32 + 4 * hh;
#pragma unroll
                for (int g = 0; g < 4; ++g) { u32x2 pk; pk[0] = pk2(oa[4 * g], oa[4 * g + 1]); pk[1] = pk2(oa[4 * g + 2], oa[4 * g + 3]); *(u32x2*)(og + 8 * g) = pk; }
            }
        }
        bf16_t* kvt = (bf16_t*)p.KVT + (size_t)it * 32768;
#pragma unroll
        for (int di = 0; di < 4; ++di) {
            f32x16 acc;
#pragma unroll
            for (int i = 0; i < 16; ++i) acc[i] = 0.f;
#pragma unroll
            for (int ks = 0; ks < 4; ++ks) { const bf16x8 bq = *(const bf16x8*)(Ket + (di * 32 + r) * 72 + 16 * ks + 8 * hh); acc = MFMA32(bq, av[ks], acc); }
#pragma unroll
            for (int g = 0; g < 4; ++g) { u32x2 pk; pk[0] = pk2(acc[4 * g], acc[4 * g + 1]); pk[1] = pk2(acc[4 * g + 2], acc[4 * g + 3]); *(u32x2*)(kvt + (wid * 32 + r) * 128 + di * 32 + 8 * g + 4 * hh) = pk; }
        }
    }
}

DI void gla_scan(const Params& p, int l) {
    const int tid = tid_opaque();
    for (int idx = blockIdx.x * 512 + tid; idx < MT * 8; idx += gridDim.x * 512) {
        const int row = idx >> 3, hd = idx & 7; const float lf = logsig(p.EX[(size_t)row * 32 + 16 + hd] + p.b_fox_f[l * 8 + hd]);
        if (row < NP) p.out[O_LFP + ((size_t)l * NP + row) * 8 + hd] = lf; else p.out[O_LFS + ((size_t)l * NS + row - NP) * 8 + hd] = lf;
    }
    for (int t = blockIdx.x; t < 768; t += gridDim.x) {
        const int grp = t >= 256 ? 1 : 0, u = grp ? t - 256 : t, seq = u >> 4, vt = u & 15;
        const int nch = grp ? 1 : 32, item0 = grp ? 512 + seq : seq * 32;
        const int v = vt * 16 + (tid & 15), d0 = (tid >> 4) * 4;
        float S[4];
        if (grp) {
            const float* sin = p.state_gla + (((size_t)l * 32 + seq) * 128 + d0) * 256 + v;
#pragma unroll
            for (int j = 0; j < 4; ++j) S[j] = sin[(size_t)j * 256];
        } else {
#pragma unroll
            for (int j = 0; j < 4; ++j) S[j] = 0.f;
        }
#pragma unroll 8
        for (int n = 0; n < nch; ++n) {
            const size_t it = (size_t)(item0 + n);
            u32x2 pk; pk[0] = pk2(S[0], S[1]); pk[1] = pk2(S[2], S[3]);
            *(u32x2*)(p.SS + it * 32768 + (size_t)v * 128 + d0) = pk;
            const u32x2 kb = *(const u32x2*)((const bf16_t*)p.KVT + it * 32768 + (size_t)v * 128 + d0); const f32x4 c0 = *(const f32x4*)(p.DEC + it * 128 + d0);
            f32x4 k0; k0[0] = bflo(kb[0]); k0[1] = bfhi(kb[0]); k0[2] = bflo(kb[1]); k0[3] = bfhi(kb[1]);
#pragma unroll
            for (int j = 0; j < 4; ++j) S[j] = c0[j] * S[j] + k0[j];
        }
        float* so = (grp ? p.out + O_STS + (((size_t)l * 32 + seq) * 128 + d0) * 256 : p.out + O_STP + (((size_t)l * 16 + seq) * 128 + d0) * 256) + v;
#pragma unroll
        for (int j = 0; j < 4; ++j) so[(size_t)j * 256] = S[j];
    }
}

DI void gla_c_stage(const Params& p, int l, char* shm) {
    const int tid = tid_opaque(), wid = tid >> 6, lane = tid & 63, r = lane & 31, hh = lane >> 5;
    for (int wt = wid * (int)gridDim.x + (int)blockIdx.x; wt < 1088; wt += 8 * (int)gridDim.x) {
        const int it = wt >> 1, ci = wt & 1;
        const int grp = it >= 512 ? 1 : 0;
        if (grp && ci) continue;
        const int h = grp ? (it & 3) : ((it >> 5) & 3);
        const size_t rowc = grp ? (size_t)NP + (size_t)((it - 512) >> 2) * 32 : (size_t)(it >> 7) * 2048 + (size_t)(it & 31) * 64;
        const size_t row = rowc + ci * 32 + r;
        bf16x8 bq[8];
#pragma unroll
        for (int ks = 0; ks < 8; ++ks) bq[ks] = *(const bf16x8*)(p.QI + row * 512 + h * 128 + 16 * ks + 8 * hh);
        f32x16 acc[8];
        float ss = 0.f;
#pragma unroll
        for (int vt = 0; vt < 8; ++vt) {
            const bf16_t* og = (const bf16_t*)p.OG + row * 1024 + h * 256 + vt * 32 + 4 * hh;
#pragma unroll
            for (int g = 0; g < 4; ++g) { const u32x2 v = *(const u32x2*)(og + 8 * g); acc[vt][4 * g] = bflo(v[0]); acc[vt][4 * g + 1] = bfhi(v[0]); acc[vt][4 * g + 2] = bflo(v[1]); acc[vt][4 * g + 3] = bfhi(v[1]); }
            const bf16_t* ssp = p.SS + (size_t)it * 32768 + (size_t)(vt * 32 + r) * 128 + 8 * hh;
#pragma unroll
            for (int ks = 0; ks < 8; ++ks) { const bf16x8 a = *(const bf16x8*)(ssp + 16 * ks); acc[vt] = MFMA32(a, bq[ks], acc[vt]); }
#pragma unroll
            for (int i = 0; i < 16; ++i) ss += acc[vt][i] * acc[vt][i];
        }
        ss += __shfl_xor(ss, 32);
        const float rs = rsqrtf(ss * (1.0f / 256.0f) + EPS);
#pragma unroll
        for (int vt = 0; vt < 8; ++vt) {
            const int vc = h * 256 + vt * 32 + 4 * hh;
#pragma unroll
            for (int g = 0; g < 4; ++g) {
                const f32x4 gn = *(const f32x4*)(p.g_onorm + (size_t)l * 1024 + vc + 8 * g);
                const u32x2 rg = *(const u32x2*)(p.Z + row * NZ + 2048 + vc + 8 * g);
                const float r0 = bflo(rg[0]), r1 = bfhi(rg[0]), r2 = bflo(rg[1]), r3 = bfhi(rg[1]);
                const float o0 = acc[vt][4 * g] * rs * gn[0] * (r0 / (1.0f + exp_fast(-r0))), o1 = acc[vt][4 * g + 1] * rs * gn[1] * (r1 / (1.0f + exp_fast(-r1)));
                const float o2 = acc[vt][4 * g + 2] * rs * gn[2] * (r2 / (1.0f + exp_fast(-r2))), o3 = acc[vt][4 * g + 3] * rs * gn[3] * (r3 / (1.0f + exp_fast(-r3)));
                u32x2 pk; pk[0] = pk2(o0, o1); pk[1] = pk2(o2, o3);
                *(u32x2*)(p.MRG + row * DM + vc + 8 * g) = pk;
            }
        }
    }
}

DI void fox_sample_item(const Params& p, int l, int b, int h, int sp, char* shm) {
    float* cs = (float*)(shm + 143360); float* wt = (float*)(shm + 151680);
    const int tid = tid_opaque(), wid = tid >> 6, lane = tid & 63, r = lane & 31, hh = lane >> 5;
    const float* lfc = p.cache_logf + ((size_t)(l * 8 + b) * 2048) * 8 + h;
    const float* lfn = p.EX + ((size_t)NP + b * 32) * 32 + 16 + h; const float fb = p.b_fox_f[l * 8 + h];
    block_cumsum(2080, [&](int i) { return i < 2048 ? lfc[(size_t)i * 8] : logsig(lfn[(size_t)(i - 2048) * 32] + fb); }, cs, wt);
    const int qpos = 2048 + r; const size_t qrow = (size_t)NP + b * 32 + r;
    bf16x8 qf[8];
    { const bf16_t* zq = p.Z + qrow * NZ + 3072 + h * 128;
#pragma unroll
      for (int ks = 0; ks < 8; ++ks) qf[ks] = *(const bf16x8*)(zq + 16 * ks + 8 * hh); }
    const float cql = cs[qpos];
    f32x16 o[4];
#pragma unroll
    for (int dt = 0; dt < 4; ++dt)
#pragma unroll
        for (int i = 0; i < 16; ++i) o[dt][i] = 0.f;
    float m = -1e30f, lsum = 0.f;
    bf16_t* Ks = (bf16_t*)(shm + wid * 17920); bf16_t* Vt = (bf16_t*)(shm + wid * 17920 + 8704);
    const int jend = sp * 17 + 17 < 65 ? sp * 17 + 17 : 65;
    for (int j = sp * 17 + wid; j < jend; j += 8) {
        const float* srcK = j < 64 ? p.cache_k + (((size_t)(l * 8 + b) * 2048 + (size_t)j * 32) * 8 + h) * 128 : p.out + O_KS + (((size_t)(l * 8 + b) * 32) * 8 + h) * 128;
        const float* srcV = j < 64 ? p.cache_v + (((size_t)(l * 8 + b) * 2048 + (size_t)j * 32) * 8 + h) * 128 : p.out + O_VS + (((size_t)(l * 8 + b) * 32) * 8 + h) * 128;
        {
            const int prow = lane >> 5, pc4 = (lane & 31) * 4;
            f32x4 kr[16], va[4];
#pragma unroll
            for (int i = 0; i < 16; ++i) kr[i] = *(const f32x4*)(srcK + (size_t)(2 * i + prow) * 1024 + pc4);
#pragma unroll
            for (int i = 0; i < 4; ++i) va[i] = *(const f32x4*)(srcV + (size_t)(2 * i + prow) * 1024 + pc4);
#pragma unroll
            for (int i = 0; i < 16; ++i) { u32x2 pk; pk[0] = pk2(kr[i][0], kr[i][1]); pk[1] = pk2(kr[i][2], kr[i][3]); *(u32x2*)(Ks + (2 * i + prow) * 136 + pc4) = pk; }
            asm volatile("" ::: "memory");
            f32x4 vb[12];
#pragma unroll
            for (int i = 0; i < 12; ++i) vb[i] = *(const f32x4*)(srcV + (size_t)(2 * (i + 4) + prow) * 1024 + pc4);
#pragma unroll
            for (int i = 0; i < 4; ++i) {
#pragma unroll
                for (int e = 0; e < 4; ++e) Vt[(pc4 + e) * 36 + 2 * i + prow] = f2bf(va[i][e]);
            }
#pragma unroll
            for (int i = 0; i < 12; ++i) {
#pragma unroll
                for (int e = 0; e < 4; ++e) Vt[(pc4 + e) * 36 + 2 * (i + 4) + prow] = f2bf(vb[i][e]);
            }
        }
        fox_tile<1>(Ks, 136, Vt, 36, cs + j * 32, j * 32, qpos, cql, qf, o, m, lsum, r, hh, j == 64);
    }
    const float lt = lsum + __shfl_xor(lsum, 32);
    __syncthreads();
    float* ml = wt;
    if (hh == 0) { ml[(wid * 32 + r) * 2] = m; ml[(wid * 32 + r) * 2 + 1] = lt; }
    __syncthreads();
    float M = -1e30f;
#pragma unroll
    for (int w = 0; w < 8; ++w) M = fmaxf(M, ml[(w * 32 + r) * 2]);
    float L = 0.f;
#pragma unroll
    for (int w = 0; w < 8; ++w) L += __builtin_amdgcn_exp2f(ml[(w * 32 + r) * 2] - M) * ml[(w * 32 + r) * 2 + 1];
    const float f = __builtin_amdgcn_exp2f(m - M);
    float* ow = (float*)shm + wid * (32 * 132);
#pragma unroll
    for (int dt = 0; dt < 4; ++dt)
#pragma unroll
        for (int g = 0; g < 4; ++g) {
            f32x4 v; v[0] = o[dt][4 * g] * f; v[1] = o[dt][4 * g + 1] * f; v[2] = o[dt][4 * g + 2] * f; v[3] = o[dt][4 * g + 3] * f;
            *(f32x4*)(ow + r * 132 + dt * 32 + 8 * g + 4 * hh) = v;
        }
    const int slot = ((b * 8 + h) * 4 + sp);
    if (wid == 0 && hh == 0) { p.FSML[(size_t)(slot * 32 + r) * 2] = M; p.FSML[(size_t)(slot * 32 + r) * 2 + 1] = L; }
    __syncthreads();
    {
        const int q = tid >> 4, d8 = (tid & 15) * 8; float acc[8];
#pragma unroll
        for (int e = 0; e < 8; ++e) acc[e] = 0.f;
#pragma unroll
        for (int w = 0; w < 8; ++w) {
            const float* src = (const float*)shm + w * (32 * 132) + q * 132 + d8;
            const f32x4 a = *(const f32x4*)src, c = *(const f32x4*)(src + 4);
#pragma unroll
            for (int e = 0; e < 4; ++e) { acc[e] += a[e]; acc[4 + e] += c[e]; }
        }
        float* dst = p.FSO + ((size_t)slot * 32 + q) * 128 + d8;
        f32x4 v0, v1; v0[0] = acc[0]; v0[1] = acc[1]; v0[2] = acc[2]; v0[3] = acc[3]; v1[0] = acc[4]; v1[1] = acc[5]; v1[2] = acc[6]; v1[3] = acc[7];
        *(f32x4*)dst = v0; *(f32x4*)(dst + 4) = v1;
    }
}

DI void fox_sample_combine(const Params& p) {
    for (int idx = blockIdx.x * 512 + tid_opaque(); idx < 64 * 32 * 16; idx += gridDim.x * 512) {
        const int d8 = (idx & 15) * 8, q = (idx >> 4) & 31, bh = idx >> 9;
        float ms[4], ls[4], M = -1e30f;
#pragma unroll
        for (int s = 0; s < 4; ++s) { ms[s] = p.FSML[(size_t)((bh * 4 + s) * 32 + q) * 2]; ls[s] = p.FSML[(size_t)((bh * 4 + s) * 32 + q) * 2 + 1]; M = fmaxf(M, ms[s]); }
        float L = 0.f, acc[8];
#pragma unroll
        for (int e = 0; e < 8; ++e) acc[e] = 0.f;
#pragma unroll
        for (int s = 0; s < 4; ++s) {
            const float w = __builtin_amdgcn_exp2f(ms[s] - M); L += w * ls[s];
            const float* src = p.FSO + ((size_t)(bh * 4 + s) * 32 + q) * 128 + d8;
            const f32x4 a = *(const f32x4*)src, c = *(const f32x4*)(src + 4);
#pragma unroll
            for (int e = 0; e < 4; ++e) { acc[e] += w * a[e]; acc[4 + e] += w * c[e]; }
        }
        const float inv = 1.0f / L;
        u32x4 pk; pk[0] = pk2(acc[0] * inv, acc[1] * inv); pk[1] = pk2(acc[2] * inv, acc[3] * inv); pk[2] = pk2(acc[4] * inv, acc[5] * inv); pk[3] = pk2(acc[6] * inv, acc[7] * inv);
        *(u32x4*)(p.MRG + ((size_t)NP + (bh >> 3) * 32 + q) * DM + 1024 + (bh & 7) * 128 + d8) = pk;
    }
}

DI int pop_item(unsigned* ctr, char* shm) {
    volatile int* sitem = (volatile int*)(shm + LDS_ITEM_OFF);
    __syncthreads();
    if (tid_opaque() == 0) *sitem = (int)atomicAdd(ctr, 1u);
    __syncthreads();
    return *sitem;
}
template <int WHICH>
DI void mixer_phase(const Params& p, int l, char* shm, int coff) {
    if constexpr (WHICH & 1) for (;;) {
        const int j = pop_item(p.ctr + coff + l * 4 + 1, shm);
        if (j >= 256) break;
        fox_prompt_item(p, l, (j & 31) >> 3, j & 7, 7 - (j >> 5), shm);
    }
    if constexpr (WHICH == 7) for (;;) {
        const int j = pop_item(p.ctr + 16 + l, shm);
        if (j >= (33 - RG_IN) * 4) break;
        EpiIn E; E.Z = p.Z; E.EX = p.EX; E.row_base = RG_IN * 256; E.pn_base = 8; E.outk_p = E.outv_p = E.outk_s = E.outv_s = nullptr;
        run_gemm(shm, p.H + (size_t)RG_IN * 256 * DM, p.WinT + (size_t)l * NIN * DM + (size_t)2048 * DM, (33 - RG_IN) * 256, 1024, DM, DM, DM, 1, E, (33 - RG_IN) * 4, j);
    }
    if constexpr (WHICH & 2) for (;;) {
        const int j = pop_item(p.ctr + coff + l * 4 + 2, shm);
        if (j >= 256) break;
        fox_sample_item(p, l, j >> 5, (j >> 2) & 7, j & 3, shm);
    }
    if constexpr (WHICH & 4) for (;;) {
        const int item = pop_item(p.ctr + coff + l * 4 + 0, shm);
        if (item >= 544) break;
        gla_a_item(p, l, item, shm);
    }
}

constexpr int NPHASE = 17;
constexpr int SPLIT_OUT = 8, SPLIT_DOWN = 16;
template <int S>
DI void run_stage(const Params& p, int l, char* shm) {
    float* yp = p.out + O_YP; float* ys = p.out + O_YS;
    if constexpr (S == 8) { phase0(p, shm); }
    if constexpr (S == 0) { EpiIn E; E.Z = p.Z; E.EX = p.EX; E.row_base = 0; E.pn_base = 0; E.outk_p = p.out + O_KP + (size_t)l * NP * 1024; E.outv_p = p.out + O_VP + (size_t)l * NP * 1024;
              E.outk_s = p.out + O_KS + (size_t)l * NS * 1024; E.outv_s = p.out + O_VS + (size_t)l * NS * 1024;
              pg8::Gemm g; g.A = p.H; g.Bt = p.WinT + (size_t)l * NIN * DM; g.M = MT; g.N = NIN; g.K = DM; g.lda = DM; g.ldb = DM; g.nct = NIN / 256; g.ksub = DM;
              InOrder S0; S0.init((int)gridDim.x, (int)blockIdx.x);
              pg8::gemm_phase<EpiIn, InOrder, false>((PG8_LAS unsigned char*)shm, g, S0, E, nullptr); }
    if constexpr (S == 1) mixer_phase<7>(p, l, shm, 0);
#if defined(PROBE) && PROBE >= 3 && PROBE <= 5
    if constexpr (S == 9) mixer_phase<(PROBE == 3 ? 1 : PROBE == 4 ? 2 : 4)>(p, l, shm, 8);
#endif
    if constexpr (S == 12) mixer_phase<7>(p, l, shm, 8);
    if constexpr (S == 2) { fox_sample_combine(p); gla_scan(p, l); }
    if constexpr (S == 10) gla_c_stage(p, l, shm);
    if constexpr (S == 3) { EpiRaw E; E.C = p.RAW; run_gemm(shm, p.MRG, p.WoutT + (size_t)l * DM * DM, NP, DM, DM, DM, DM, 1, E);
              EpiPart EP; EP.P = (bf16_t*)p.PART; run_gemm(shm, p.MRG + (size_t)NP * DM, p.WoutT + (size_t)l * DM * DM, NS, DM, DM / SPLIT_OUT, DM, DM, SPLIT_OUT, EP); }
    if constexpr (S == 14)
        norm_rows(l == 0 ? p.x_prompt : yp, l == 0 ? p.x_sample : ys, p.RAW, p.PART, SPLIT_OUT, p.g_mix_post + (size_t)l * DM, p.g_mlp_pre + (size_t)l * DM, yp, ys, p.H, NP, MT, (int)blockIdx.x, (int)gridDim.x, true, l == 0 ? nullptr : p.YB, p.YB);
    if constexpr (S == 4) {
        const int ng = (int)gridDim.x - 32;
        if ((int)blockIdx.x >= ng) { EpiUp E; E.U = p.U + (size_t)NP * DFF; run_gemm(shm, p.H + (size_t)NP * DM, p.WupT + (size_t)l * DFF * DM, NS, DFF, DM, DM, DM, 1, E, 32, (int)blockIdx.x - ng); }
        else norm_rows(l == 0 ? p.x_prompt : yp, l == 0 ? p.x_sample : ys, p.RAW, p.PART, SPLIT_OUT, p.g_mix_post + (size_t)l * DM, p.g_mlp_pre + (size_t)l * DM, yp, ys, p.H, 0, NP, (int)blockIdx.x, ng, false, l == 0 ? nullptr : p.YB, p.YB);
    }
    if constexpr (S == 5) { EpiUp E; E.U = p.U; run_gemm(shm, p.H, p.WupT + (size_t)l * DFF * DM, NP, DFF, DM, DM, DM, 1, E); }
    if constexpr (S == 6) { EpiRaw E; E.C = p.RAW; run_gemm(shm, p.U, p.WdownT + (size_t)l * DM * DFF, NP, DM, DFF, DFF, DFF, 1, E);
              EpiPart EP; EP.P = (bf16_t*)p.PART; run_gemm(shm, p.U + (size_t)NP * DFF, p.WdownT + (size_t)l * DM * DFF, NS, DM, DFF / SPLIT_DOWN, DFF, DFF, SPLIT_DOWN, EP); }
    if constexpr (S == 7) {
        const float* gn = l + 1 < 2 ? p.g_mix_pre + (size_t)(l + 1) * DM : nullptr;
        norm_rows(yp, ys, p.RAW, p.PART, SPLIT_DOWN, p.g_mlp_post + (size_t)l * DM, gn, yp, ys, p.H, NP, MT, (int)blockIdx.x, (int)gridDim.x, true, p.YB, l + 1 < 2 ? p.YB : nullptr);
        norm_rows(yp, ys, p.RAW, p.PART, SPLIT_DOWN, p.g_mlp_post + (size_t)l * DM, gn, yp, ys, p.H, 0, NP, (int)blockIdx.x, (int)gridDim.x, false, p.YB, l + 1 < 2 ? p.YB : nullptr);
    }
}

#if MEGA
DI Params load_params() {
    Params r{};
#if defined(__HIP_DEVICE_COMPILE__)
    const __attribute__((address_space(4))) unsigned long long* kp = (const __attribute__((address_space(4))) unsigned long long*)__builtin_amdgcn_kernarg_segment_ptr();
    asm volatile("" : "+s"(kp));
    unsigned long long* d = (unsigned long long*)&r;
#pragma unroll
    for (int i = 0; i < (int)(sizeof(Params) / 8); ++i) d[i] = kp[i];
#endif
    return r;
}
__global__ void __launch_bounds__(512, 2) k_mega(Params p_unused) {
    extern __shared__ __attribute__((aligned(16))) char shm[];
    cg::grid_group grid = cg::this_grid();
    volatile LAS unsigned* st = (volatile LAS unsigned*)(shm + LDS_ITEM_OFF + 16);
    if (threadIdx.x < 2) st[threadIdx.x] = 0u;
    __syncthreads();
    XcdBarrier bar;
    { const Params q = load_params(); bar = xcd_barrier_post(q.bar, st); }
#define STAGE(S, l) { const Params q = load_params(); run_stage<S>(q, l, shm); }
#if PROBE == 11
#define SYNC() xcd_barrier(bar); xcd_barrier(bar);
#else
#define SYNC() xcd_barrier(bar);
#endif
    { const Params q = load_params(); if (q.bar == nullptr) grid.sync(); }
    STAGE(8, 0)
    if (PROBE == 1) { SYNC() STAGE(8, 0) }
    SYNC()
    STAGE(0, 0)
#define DUP(n, S, l) if (PROBE == n) { SYNC() STAGE(S, l) }
#define LAYER_REST(l) DUP(2, 0, l) SYNC() STAGE(1, l) if (PROBE >= 3 && PROBE <= 5) { SYNC() STAGE(9, l) } if (PROBE == 12) { SYNC() STAGE(12, l) } SYNC() STAGE(2, l) SYNC() STAGE(10, l) if (PROBE == 8) { SYNC() STAGE(2, l) SYNC() STAGE(10, l) } \
    SYNC() STAGE(3, l) DUP(9, 3, l) SYNC() STAGE(14, l) SYNC() STAGE(4, l) SYNC() STAGE(5, l) DUP(6, 5, l) SYNC() STAGE(6, l) DUP(7, 6, l) SYNC() STAGE(7, l)
    LAYER_REST(0)
    SYNC() STAGE(0, 1)
    LAYER_REST(1)
#undef LAYER_REST
#undef SYNC
#undef STAGE
}
#else
template <int S>
__global__ void __launch_bounds__(512, 2) k_one(Params p, int l) {
    extern __shared__ __attribute__((aligned(16))) char shm[];
    run_stage<S>(p, l, shm);
}
template <int S> static void launch_one(const Params& p, int l, hipStream_t stream) {
    (void)hipFuncSetAttribute((const void*)k_one<S>, hipFuncAttributeMaxDynamicSharedMemorySize, LDS_BYTES);
    hipLaunchKernelGGL(k_one<S>, dim3(256), dim3(512), LDS_BYTES, stream, p, l);
}
#endif

extern "C" void kernel_launch(void* const* d_in, const int* in_sizes, int n_in, void* d_out, int out_size, void* d_ws, size_t ws_size, hipStream_t stream) {
    Params p{};
    const float* const* in = (const float* const*)d_in;
    p.x_prompt = in[0]; p.x_sample = in[1]; p.cache_k = in[2]; p.cache_v = in[3]; p.cache_logf = in[4]; p.state_gla = in[5]; p.g_mix_pre = in[6]; p.w_in = in[7];
    p.w_gate_up = in[8]; p.b_gate = in[9]; p.b_fox_f = in[10]; p.g_onorm = in[11]; p.w_out = in[12]; p.g_mix_post = in[13]; p.g_mlp_pre = in[14]; p.w_up = in[15];
    p.w_down = in[16]; p.g_mlp_post = in[17];
    p.out = (float*)d_out;
    char* w = (char*)d_ws; size_t off = 0;
    auto take = [&](size_t bytes) { char* r = w + off; off += (bytes + 255) & ~(size_t)255; return r; };
    p.ctr = (unsigned*)take(256);
    p.bar = (unsigned*)take((size_t)XCD_BAR_WORDS * 4);
    p.WinT = (bf16_t*)take((size_t)2 * NIN * DM * 2); p.WoutT = (bf16_t*)take((size_t)2 * DM * DM * 2);
    p.WupT = (bf16_t*)take((size_t)2 * DFF * DM * 2); p.WdownT = (bf16_t*)take((size_t)2 * DM * DFF * 2);
    p.H = (bf16_t*)take((size_t)MT * DM * 2); p.MRG = (bf16_t*)take((size_t)MT * DM * 2); p.Z = (bf16_t*)take((size_t)MT * NZ * 2);
    p.U = (bf16_t*)take((size_t)MT * DFF * 2);
    p.EX = (float*)take((size_t)MT * 32 * 4); p.RAW = (bf16_t*)take((size_t)MT * DM * 2); p.YB = (bf16_t*)take((size_t)MT * DM * 2); p.OG = (float*)take((size_t)MT * 1024 * 4); p.DEC = (float*)take((size_t)544 * 128 * 4); p.PART = (float*)take((size_t)SPLIT_DOWN * 256 * DM * 4);
    p.FSO = (float*)take((size_t)256 * 32 * 128 * 4); p.FSML = (float*)take((size_t)256 * 32 * 2 * 4);
    p.KVT = (float*)p.U; p.SS = (bf16_t*)((char*)p.U + (size_t)544 * 32768 * 4); p.QI = (bf16_t*)((char*)p.U + (size_t)544 * 32768 * 6);
    if (off > ws_size) { fprintf(stderr, "workspace too small: need %zu have %zu\n", off, ws_size); return; }
#if MEGA
    static int grid_blocks = 0;
    if (!grid_blocks) {
        (void)hipFuncSetAttribute((const void*)k_mega, hipFuncAttributeMaxDynamicSharedMemorySize, LDS_BYTES);
        int dev = 0, cus = 0, per_cu = 0; hipGetDevice(&dev); hipDeviceGetAttribute(&cus, hipDeviceAttributeMultiprocessorCount, dev);
        hipOccupancyMaxActiveBlocksPerMultiprocessor(&per_cu, k_mega, 512, LDS_BYTES);
        if (per_cu < 1) per_cu = 1;
        grid_blocks = cus;
    }
    (void)hipMemsetAsync(p.bar, 0, (size_t)XCD_BAR_WORDS * 4, stream);
    void* args[] = {&p};
    hipError_t e = hipLaunchCooperativeKernel((void*)k_mega, dim3(grid_blocks), dim3(512), args, LDS_BYTES, stream);
    if (e != hipSuccess) fprintf(stderr, "cooperative launch failed: %s (grid %d)\n", hipGetErrorString(e), grid_blocks);
#else
    launch_one<8>(p, 0, stream);
    for (int l = 0; l < 2; ++l) { launch_one<0>(p, l, stream); launch_one<1>(p, l, stream); launch_one<2>(p, l, stream); launch_one<10>(p, l, stream); launch_one<3>(p, l, stream);
        launch_one<14>(p, l, stream); launch_one<4>(p, l, stream); launch_one<5>(p, l, stream); launch_one<6>(p, l, stream); launch_one<7>(p, l, stream); }
#endif
}
```

```cpp
#include <hip/hip_runtime.h>
#include <hip/hip_cooperative_groups.h>
#include <cstdio>
namespace cg = cooperative_groups;
#ifndef MEGA
#define MEGA 1
#endif
#ifndef PROBE
#define PROBE 0
#endif
__device__ __forceinline__ int tid_opaque() { int t = threadIdx.x; asm volatile("" : "+v"(t)); return t; }
#define XB_TMO      128
#define XB_XCNT(j)  (256  + 64 * (j))
#define XB_XSUB(j)  (1280 + 64 * (j))
#define XB_XGEN(j)  (2304 + 64 * (j))
#define XB_TOP      3328
#define XB_TOPGEN   3392
#define XCD_BAR_WORDS 3456
#define XB_SPIN_CAP (1u << 18)
#define LAS __attribute__((address_space(3)))

__device__ __forceinline__ unsigned xb_ld(unsigned* p)              { return __hip_atomic_load(p, __ATOMIC_RELAXED, __HIP_MEMORY_SCOPE_AGENT); }
__device__ __forceinline__ unsigned xb_add(unsigned* p, unsigned v) { return __hip_atomic_fetch_add(p, v, __ATOMIC_RELAXED, __HIP_MEMORY_SCOPE_AGENT); }
__device__ __forceinline__ unsigned xb_xcc_id() { return (unsigned)__builtin_amdgcn_s_getreg((3 << 11) | 20) & 0xFu; }
#define XB_SPIN(cond, bar) do { unsigned _sp = 0; while (cond) { __builtin_amdgcn_s_sleep(1); \
    if ((++_sp & 255u) == 0u) { if (xb_ld(&(bar)[XB_TMO])) break; if (_sp > XB_SPIN_CAP) { atomicAdd(&(bar)[XB_TMO], 1u); break; } } } } while (0)

struct XcdBarrier {
    unsigned* bar; unsigned x;
    volatile LAS unsigned* st;
};

__device__ __forceinline__ XcdBarrier xcd_barrier_post(unsigned* bar, volatile LAS unsigned* st) {
    XcdBarrier b; b.bar = bar; b.x = xb_xcc_id(); b.st = st;
    if (threadIdx.x == 0) (void)xb_add(&bar[XB_XCNT(b.x)], 1u);
    return b;
}
__device__ __forceinline__ void xcd_barrier_complete(unsigned* bar, unsigned x, unsigned& nloc, unsigned& nx) {
    const unsigned G = gridDim.x * gridDim.y * gridDim.z;
    unsigned sum, cnt, mine, sp = 0u;
    for (;;) {
        sum = 0u; cnt = 0u; mine = 0u;
#pragma unroll
        for (unsigned j = 0; j < 16; ++j) { const unsigned c = xb_ld(&bar[XB_XCNT(j)]); sum += c; cnt += (c > 0u) ? 1u : 0u; mine = (j == x) ? c : mine; }
        if (sum == G) break;
        __builtin_amdgcn_s_sleep(1);
        if ((++sp & 255u) == 0u) { if (xb_ld(&bar[XB_TMO])) break; if (sp > XB_SPIN_CAP) { atomicAdd(&bar[XB_TMO], 1u); break; } }
    }
    nloc = mine > 0u ? mine : 1u; nx = cnt > 0u ? cnt : 1u;
}

__device__ __forceinline__ void xcd_barrier(const XcdBarrier& b) {
    asm volatile("s_waitcnt vmcnt(0)" ::: "memory");
    __syncthreads();
    if (threadIdx.x == 0) {
        unsigned* bar = b.bar;
        __builtin_amdgcn_s_waitcnt(0);
        unsigned nloc = b.st[0], nx = b.st[1];
        if (nloc == 0u) { xcd_barrier_complete(bar, b.x, nloc, nx); b.st[0] = nloc; b.st[1] = nx; }
        const unsigned old = xb_add(&bar[XB_XSUB(b.x)], 1u);
        const unsigned gen = old / nloc;
        if (old + 1u == (gen + 1u) * nloc) {
            __builtin_amdgcn_fence(__ATOMIC_RELEASE, "agent");
            asm volatile("s_waitcnt vmcnt(0)" ::: "memory");
            const unsigned og = xb_add(&bar[XB_TOP], 1u);
            const unsigned tg = og / nx;
            if (og + 1u == (tg + 1u) * nx) xb_add(&bar[XB_TOPGEN], 1u);
            else XB_SPIN(xb_ld(&bar[XB_TOPGEN]) == tg, bar);
            __builtin_amdgcn_fence(__ATOMIC_ACQUIRE, "agent");
            xb_add(&bar[XB_XGEN(b.x)], 1u);
            asm volatile("s_waitcnt vmcnt(0)" ::: "memory");
        } else {
            XB_SPIN(xb_ld(&bar[XB_XGEN(b.x)]) == gen, bar);
            __builtin_amdgcn_fence(__ATOMIC_ACQUIRE, "agent");
            asm volatile("s_waitcnt vmcnt(0)" ::: "memory");
        }
    }
    __syncthreads();
}
namespace pg8 {
#define PG8_LAS __attribute__((address_space(3)))
typedef unsigned short bf16_t;
typedef short bf16x8 __attribute__((ext_vector_type(8)));
typedef float f32x4 __attribute__((ext_vector_type(4)));
typedef unsigned u32x4 __attribute__((ext_vector_type(4)));
constexpr int BM = 256, BK = 64, HALF = 128, HTB = HALF * BK * 2  , STAGE_BYTES = 8 * HTB, NXCD = 8, WGM = 8;

__host__ __device__ __forceinline__ int lds_byte(int r, int c) { const int st = (r >> 4) * 2 + (c >> 5), rr = r & 15, cc = c & 31, ob = rr * 64 + cc * 2; return st * 1024 + (ob ^ (((ob >> 9) & 1) << 5)); }
__host__ __device__ __forceinline__ void stage_rc(int b, int& R, int& C) { const int st = b / 1024, sb = b % 1024, swz = sb ^ (((sb >> 9) & 1) << 5); R = (st >> 1) * 16 + swz / 64; C = (st & 1) * 32 + (swz % 64) / 2; }
__host__ __device__ __forceinline__ int perm32(int rho) { const int n = rho >> 4, i = rho & 15; return 8 * (i >> 2) + 4 * n + (i & 3); }

struct Unit { int pm, pn; };
struct Gemm { const bf16_t* A; const bf16_t* Bt; int M, N, K; int lda, ldb, nct, ksub; };

struct StaticOrder {
    int nM, nN, nwg, G, c;
    __host__ __device__ void init(int M, int N, int G_, int c_) { nM = M / BM; nN = N / BM; nwg = nM * nN; G = G_; c = c_; }
    __host__ __device__ bool next(int i, Unit& u) const {
        const long L = (long)i * G + c; if (L >= nwg) return false;
        int wgid = (int)L; { const int q = nwg / NXCD, r = nwg % NXCD, xcd = wgid % NXCD, off = wgid / NXCD; wgid = (xcd < r ? xcd * (q + 1) : r * (q + 1) + (xcd - r) * q) + off; }
        const int nig = WGM * nN, gid = wgid / nig, fm = gid * WGM, gsz = (nM - fm) < WGM ? (nM - fm) : WGM;
        u.pm = fm + ((wgid % nig) % gsz); u.pn = (wgid % nig) / gsz; return true;
    }
    __device__ __forceinline__ void a_ready(const Unit&) const {}
    __device__ __forceinline__ void done(const Unit&) const {}
};

template <class Epi, class Sched, bool STAMP = false>
__device__ __forceinline__ void gemm_phase(PG8_LAS unsigned char* lds, const Gemm g, const Sched& S, const Epi& E, unsigned long long* stamps) {
    const int tid = tid_opaque(), wid = __builtin_amdgcn_readfirstlane(tid >> 6), lane = tid & 63, wr = wid >> 2, wc = wid & 3, fr = lane & 15, fq = lane >> 4;
    const int K = g.K, nt = K / BK;
    int ts_lo = 0, ts_hi = 0, nts = 0; const unsigned long long rt_entry = STAMP ? (unsigned long long)wall_clock64() : 0ull;
#define PG8_STAMP() do { if (STAMP && wid == 0 && nts < 64) { const unsigned long long _c = (unsigned long long)clock64(); \
        ts_lo = (lane == nts) ? (int)(unsigned)_c : ts_lo; ts_hi = (lane == nts) ? (int)(unsigned)(_c >> 32) : ts_hi; ++nts; } } while (0)
    PG8_STAMP();
    unsigned voffA[2], voffB[2];
#pragma unroll
    for (int i = 0; i < 2; ++i) { int R, C; stage_rc(tid * 16 + i * 8192, R, C); const int Rb = Epi::PERM ? ((R & ~31) + perm32(R & 31)) : R;
        voffA[i] = (unsigned)(R * g.lda + C) * 2u; voffB[i] = (unsigned)(Rb * g.ldb + C) * 2u; }
    const size_t kstep = (size_t)(BK * 2);
    const size_t hstepA = (size_t)HALF * g.lda * 2, hstepB = (size_t)HALF * g.ldb * 2;
    const size_t tstepA = 2 * hstepA, tstepB = 2 * hstepB;
    const unsigned ldsw = (unsigned)wid * 1024u;
    const int aoff = lds_byte(wr * 64 + fr, fq * 8), boff = lds_byte(wc * 32 + fr, fq * 8);
#define PG8_SA(b, h) (((b) * 2 + (h)) * HTB)
#define PG8_SB(b, h) ((4 + (b) * 2 + (h)) * HTB)
#define PG8_STAGE(bufoff, gbase, voff) do { _Pragma("unroll") for (int _i = 0; _i < 2; ++_i) \
        __builtin_amdgcn_global_load_lds((const unsigned*)((const char*)(gbase) + (voff)[_i]), (PG8_LAS unsigned*)(lds + (bufoff) + ldsw + _i * 8192), 16, 0, 0); } while (0)
#define PG8_LDA(dst, b, h) do { _Pragma("unroll") for (int m = 0; m < 4; ++m) _Pragma("unroll") for (int k = 0; k < 2; ++k) dst[m][k] = *(const PG8_LAS bf16x8*)(lds + PG8_SA(b, h) + aoff + m * 2048 + k * 1024); } while (0)
#define PG8_LDB(dst, b, h) do { _Pragma("unroll") for (int n = 0; n < 2; ++n) _Pragma("unroll") for (int k = 0; k < 2; ++k) dst[n][k] = *(const PG8_LAS bf16x8*)(lds + PG8_SB(b, h) + boff + n * 2048 + k * 1024); } while (0)
#define PG8_MMA(ai, bj, At, Bt) do { __builtin_amdgcn_s_setprio(1); _Pragma("unroll") for (int m = 0; m < 4; ++m) _Pragma("unroll") for (int n = 0; n < 2; ++n) _Pragma("unroll") for (int k = 0; k < 2; ++k) \
        acc[ai][bj][m][n] = __builtin_amdgcn_mfma_f32_16x16x32_bf16(Bt[n][k], At[m][k], acc[ai][bj][m][n], 0, 0, 0); __builtin_amdgcn_s_setprio(0); } while (0)
#define PG8_WAIT_V(n) asm volatile("s_waitcnt vmcnt(" #n ")" ::: "memory")
#define PG8_WAIT_L(n) asm volatile("s_waitcnt lgkmcnt(" #n ")" ::: "memory")
#define PG8_BAR __builtin_amdgcn_s_barrier()
#define PG8_SCHED __builtin_amdgcn_sched_barrier(0)
    Unit cur, nxt; int ui = 0;
    if (!S.next(0, cur)) return;
    f32x4 acc[2][2][4][2];
#pragma unroll
    for (int a = 0; a < 2; ++a)
#pragma unroll
        for (int b = 0; b < 2; ++b)
#pragma unroll
            for (int m = 0; m < 4; ++m)
#pragma unroll
                for (int n = 0; n < 2; ++n) acc[a][b][m][n] = (f32x4){0.f, 0.f, 0.f, 0.f};
    bf16x8 At[4][2], B0[2][2], B1[2][2];
    const char* cA = (const char*)g.A + (size_t)cur.pm * tstepA + (size_t)(cur.pn / g.nct) * g.ksub * 2; const char* cB = (const char*)g.Bt + (size_t)(cur.pn % g.nct) * tstepB + (size_t)(cur.pn / g.nct) * g.ksub * 2;
    S.a_ready(cur);
    PG8_STAGE(PG8_SB(0, 0), cB, voffB); PG8_STAGE(PG8_SA(0, 0), cA, voffA); PG8_STAGE(PG8_SB(0, 1), cB + hstepB, voffB); PG8_STAGE(PG8_SA(0, 1), cA + hstepA, voffA);
    if (wr == 1) PG8_BAR;
    PG8_WAIT_V(4); PG8_BAR;
    PG8_STAGE(PG8_SB(1, 0), cB + kstep, voffB); PG8_STAGE(PG8_SA(1, 0), cA + kstep, voffA); PG8_STAGE(PG8_SB(1, 1), cB + hstepB + kstep, voffB);
    PG8_WAIT_V(6); PG8_BAR;
    PG8_STAMP();
    for (;;) {
        const bool has_next = S.next(ui + 1, nxt);
        const char* nA = has_next ? (const char*)g.A + (size_t)nxt.pm * tstepA + (size_t)(nxt.pn / g.nct) * g.ksub * 2 : cA; const char* nB = has_next ? (const char*)g.Bt + (size_t)(nxt.pn % g.nct) * tstepB + (size_t)(nxt.pn / g.nct) * g.ksub * 2 : cB;
        for (int t = 0; t < nt; t += 2) {
            const bool last = (t == nt - 2);
            const char* a1 = cA + (size_t)(t + 1) * kstep;
            const char* a2 = last ? nA : cA + (size_t)(t + 2) * kstep; const char* b2 = last ? nB : cB + (size_t)(t + 2) * kstep;
            const char* a3 = a2 + kstep; const char* b3 = b2 + kstep;
            if (last && has_next) S.a_ready(nxt);
            PG8_LDB(B0, 0, 0); PG8_SCHED; PG8_LDA(At, 0, 0); PG8_STAGE(PG8_SA(1, 1), a1 + hstepA, voffA);
            PG8_WAIT_L(8); PG8_BAR; PG8_WAIT_L(0); PG8_MMA(0, 0, At, B0); PG8_BAR; PG8_SCHED;
            PG8_LDB(B1, 0, 1); PG8_STAGE(PG8_SB(0, 0), b2, voffB);
            PG8_BAR; PG8_WAIT_L(0); PG8_MMA(0, 1, At, B1); PG8_BAR;
            PG8_LDA(At, 0, 1); PG8_STAGE(PG8_SA(0, 0), a2, voffA);
            PG8_BAR; PG8_WAIT_L(0); PG8_MMA(1, 0, At, B0); PG8_BAR; PG8_SCHED;
            PG8_STAGE(PG8_SB(0, 1), b2 + hstepB, voffB);
            PG8_WAIT_V(6); PG8_BAR; PG8_MMA(1, 1, At, B1); PG8_BAR;
            PG8_LDB(B0, 1, 0); PG8_SCHED; PG8_LDA(At, 1, 0); PG8_STAGE(PG8_SA(0, 1), a2 + hstepA, voffA);
            PG8_WAIT_L(8); PG8_BAR; PG8_WAIT_L(0); PG8_MMA(0, 0, At, B0); PG8_BAR; PG8_SCHED;
            PG8_LDB(B1, 1, 1); PG8_STAGE(PG8_SB(1, 0), b3, voffB);
            PG8_BAR; PG8_WAIT_L(0); PG8_MMA(0, 1, At, B1); PG8_BAR;
            PG8_LDA(At, 1, 1); PG8_STAGE(PG8_SA(1, 0), a3, voffA);
            PG8_BAR; PG8_WAIT_L(0); PG8_MMA(1, 0, At, B0); PG8_BAR; PG8_SCHED;
            PG8_STAGE(PG8_SB(1, 1), b3 + hstepB, voffB);
            PG8_WAIT_V(6); PG8_BAR; PG8_MMA(1, 1, At, B1); PG8_BAR;
        }
        PG8_STAMP();
        if constexpr (!Epi::AFTER_DRAIN) { E(acc, cur, wr, wc, fr, fq); S.done(cur); }
        PG8_STAMP();
        if (!has_next) break;
#pragma unroll
        for (int a = 0; a < 2; ++a)
#pragma unroll
            for (int b = 0; b < 2; ++b)
#pragma unroll
                for (int m = 0; m < 4; ++m)
#pragma unroll
                    for (int n = 0; n < 2; ++n) acc[a][b][m][n] = (f32x4){0.f, 0.f, 0.f, 0.f};
        cur = nxt; cA = nA; cB = nB; ++ui;
    }
    PG8_WAIT_V(0);
    if (wr == 0) PG8_BAR;
    PG8_BAR;
    if constexpr (Epi::AFTER_DRAIN) { E.fused(acc, cur, wr, wc, fr, fq, lds, wid, lane); S.done(cur); }
    PG8_STAMP();
    if (STAMP && wid == 0) { stamps[lane] = lane < nts ? (((unsigned long long)(unsigned)ts_hi << 32) | (unsigned)ts_lo) : 0ull;
        if (lane == 62) stamps[62] = rt_entry; if (lane == 63) stamps[63] = (unsigned long long)wall_clock64(); }
#undef PG8_STAMP
#undef PG8_SA
#undef PG8_SB
#undef PG8_STAGE
#undef PG8_LDA
#undef PG8_LDB
#undef PG8_MMA
#undef PG8_WAIT_V
#undef PG8_WAIT_L
#undef PG8_BAR
#undef PG8_SCHED
}
}

using pg8::bf16_t; using pg8::bf16x8; using pg8::f32x4; using pg8::u32x4;
typedef short s16x4 __attribute__((ext_vector_type(4)));
typedef float f32x16 __attribute__((ext_vector_type(16)));
typedef unsigned u32x2 __attribute__((ext_vector_type(2)));
#define DI __device__ __forceinline__
#define MFMA32(a, b, c) __builtin_amdgcn_mfma_f32_32x32x16_bf16((a), (b), (c), 0, 0, 0)

constexpr int NP = 8192, NS = 256, MT = 8448, DM = 2048, NZ = 6144, NIN = 6400, DFF = 8192;
constexpr float EPS = 1e-6f, LOG2E = 1.4426950408889634f;
constexpr int LDS_BYTES = 154112;
constexpr int LDS_ITEM_OFF = 153792;
constexpr size_t O_YP = 0, O_YS = 16777216, O_KP = 17301504, O_VP = 34078720, O_LFP = 50855936, O_STP = 50987008,
                 O_KS = 52035584, O_VS = 52559872, O_LFS = 53084160, O_STS = 53088256;

struct Params {
    const float *x_prompt, *x_sample, *cache_k, *cache_v, *cache_logf, *state_gla, *g_mix_pre, *w_in, *w_gate_up, *b_gate, *b_fox_f,
                *g_onorm, *w_out, *g_mix_post, *g_mlp_pre, *w_up, *w_down, *g_mlp_post;
    float* out;
    bf16_t *WinT, *WoutT, *WupT, *WdownT, *H, *MRG, *Z, *U;
    bf16_t* RAW;
    bf16_t* YB;
    float *EX, *OG, *DEC, *KVT, *PART, *FSO, *FSML;
    bf16_t *SS, *QI;
    unsigned* ctr;
    unsigned* bar;
};

DI unsigned pk2(float a, float b) { typedef __bf16 v2 __attribute__((ext_vector_type(2))); v2 v; v[0] = (__bf16)a; v[1] = (__bf16)b; return __builtin_bit_cast(unsigned, v); }
DI bf16_t f2bf(float a) { return __builtin_bit_cast(unsigned short, (__bf16)a); }
DI float bf2f(unsigned u) { return __uint_as_float(u << 16); }
DI float bflo(unsigned u) { return __uint_as_float(u << 16); }
DI float bfhi(unsigned u) { return __uint_as_float(u & 0xffff0000u); }
DI float logsig(float x) { return fminf(x, 0.f) - log1pf(__expf(-fabsf(x))); }
DI int crow(int reg, int h) { return (reg & 3) + 8 * (reg >> 2) + 4 * h; }
DI float wave_sum(float v) {
#pragma unroll
    for (int o = 32; o >= 1; o >>= 1) v += __shfl_xor(v, o);
    return v;
}

struct EpiIn {
    static constexpr bool PERM = true, AFTER_DRAIN = false;
    bf16_t* Z; float* EX; float *outk_p, *outv_p, *outk_s, *outv_s; int row_base, pn_base;
    DI void operator()(const f32x4 (&acc)[2][2][4][2], const pg8::Unit& u, int wr, int wc, int fr, int fq) const {
        const int row0 = row_base + u.pm * 256 + wr * 64 + fr, pn = pn_base + u.pn;
        const float sc = pn < 2 ? 0.08838834764831845f : 1.0f;
#pragma unroll
        for (int ai = 0; ai < 2; ++ai)
#pragma unroll
            for (int m = 0; m < 4; ++m) {
                const int row = row0 + ai * 128 + m * 16;
#pragma unroll
                for (int bj = 0; bj < 2; ++bj) {
                    const int cc = bj * 128 + wc * 32 + 8 * fq;
                    const f32x4 v0 = acc[ai][bj][m][0], v1 = acc[ai][bj][m][1];
                    if (pn < 24) {
                        u32x4 pk; pk[0] = pk2(v0[0] * sc, v0[1] * sc); pk[1] = pk2(v0[2] * sc, v0[3] * sc); pk[2] = pk2(v1[0] * sc, v1[1] * sc); pk[3] = pk2(v1[2] * sc, v1[3] * sc);
                        *(u32x4*)(Z + (size_t)row * NZ + pn * 256 + cc) = pk;
                        if (pn >= 16) {
                            const bool isk = pn < 20; const int gc = (pn - (isk ? 16 : 20)) * 256 + cc;
                            float* dst = row < NP ? (isk ? outk_p : outv_p) + (size_t)row * 1024 + gc : (isk ? outk_s : outv_s) + (size_t)(row - NP) * 1024 + gc;
                            *(f32x4*)dst = v0; *(f32x4*)(dst + 4) = v1;
                        }
                    } else if (cc < 24) {
                        float* ex = EX + (size_t)row * 32 + cc;
                        *(f32x4*)ex = v0; *(f32x4*)(ex + 4) = v1;
                    }
                }
            }
    }
};
struct EpiRaw {
    static constexpr bool PERM = true, AFTER_DRAIN = false;
    bf16_t* C;
    DI void operator()(const f32x4 (&acc)[2][2][4][2], const pg8::Unit& u, int wr, int wc, int fr, int fq) const {
        const int row0 = u.pm * 256 + wr * 64 + fr, col0 = u.pn * 256 + wc * 32 + 8 * fq;
#pragma unroll
        for (int ai = 0; ai < 2; ++ai)
#pragma unroll
            for (int m = 0; m < 4; ++m) {
                bf16_t* rp = C + (size_t)(row0 + ai * 128 + m * 16) * DM + col0;
#pragma unroll
                for (int bj = 0; bj < 2; ++bj) {
                    const f32x4 a = acc[ai][bj][m][0], b = acc[ai][bj][m][1];
                    u32x4 pk; pk[0] = pk2(a[0], a[1]); pk[1] = pk2(a[2], a[3]); pk[2] = pk2(b[0], b[1]); pk[3] = pk2(b[2], b[3]);
                    *(u32x4*)(rp + bj * 128) = pk;
                }
            }
    }
};
struct EpiUp {
    static constexpr bool PERM = true, AFTER_DRAIN = false;
    bf16_t* U;
    DI void operator()(const f32x4 (&acc)[2][2][4][2], const pg8::Unit& u, int wr, int wc, int fr, int fq) const {
        const int row0 = u.pm * 256 + wr * 64 + fr, col0 = u.pn * 256 + wc * 32 + 8 * fq;
#pragma unroll
        for (int ai = 0; ai < 2; ++ai)
#pragma unroll
            for (int m = 0; m < 4; ++m) {
                bf16_t* rp = U + (size_t)(row0 + ai * 128 + m * 16) * DFF + col0;
#pragma unroll
                for (int bj = 0; bj < 2; ++bj) {
                    f32x4 a = acc[ai][bj][m][0], b = acc[ai][bj][m][1];
#pragma unroll
                    for (int e = 0; e < 4; ++e) { a[e] = fmaxf(a[e], 0.f); a[e] *= a[e]; b[e] = fmaxf(b[e], 0.f); b[e] *= b[e]; }
                    u32x4 pk; pk[0] = pk2(a[0], a[1]); pk[1] = pk2(a[2], a[3]); pk[2] = pk2(b[0], b[1]); pk[3] = pk2(b[2], b[3]);
                    *(u32x4*)(rp + bj * 128) = pk;
                }
            }
    }
};

struct EpiPart {
    static constexpr bool PERM = true, AFTER_DRAIN = false;
    bf16_t* P;
    DI void operator()(const f32x4 (&acc)[2][2][4][2], const pg8::Unit& u, int wr, int wc, int fr, int fq) const {
        const int split = u.pn >> 3, ct = u.pn & 7;
        const int row0 = wr * 64 + fr, col0 = ct * 256 + wc * 32 + 8 * fq;
#pragma unroll
        for (int ai = 0; ai < 2; ++ai)
#pragma unroll
            for (int m = 0; m < 4; ++m) {
                bf16_t* rp = P + ((size_t)split * 256 + row0 + ai * 128 + m * 16) * DM + col0;
#pragma unroll
                for (int bj = 0; bj < 2; ++bj) { const f32x4 a = acc[ai][bj][m][0], b = acc[ai][bj][m][1];
                    u32x4 pk; pk[0] = pk2(a[0], a[1]); pk[1] = pk2(a[2], a[3]); pk[2] = pk2(b[0], b[1]); pk[3] = pk2(b[2], b[3]); *(u32x4*)(rp + bj * 128) = pk; }
            }
    }
};

template <class Epi>
DI void run_gemm(char* shm, const bf16_t* A, const bf16_t* Bt, int M, int N, int K, int lda, int ldb, int nsplit, const Epi& E, int G = 0, int c = 0) {
    pg8::Gemm g; g.A = A; g.Bt = Bt; g.M = M; g.N = N * nsplit; g.K = K; g.lda = lda; g.ldb = ldb; g.nct = N / 256; g.ksub = K;
    if (G == 0) { G = (int)gridDim.x; c = (int)blockIdx.x; }
    pg8::StaticOrder S; S.init(M, N * nsplit, G, c);
    pg8::gemm_phase<Epi, pg8::StaticOrder, false>((PG8_LAS unsigned char*)shm, g, S, E, nullptr);
}

DI void norm_rows(const float* xin_p, const float* xin_s, const bf16_t* raw, const float* part, int nsplit, const float* gpost, const float* gnext, float* yout_p, float* yout_s, bf16_t* H,
                  int row_lo, int row_hi, int wblk, int nwblk, bool spread = false, const bf16_t* xb = nullptr, bf16_t* yb = nullptr) {
    const int lane = tid_opaque() & 63, wid = tid_opaque() >> 6;
    f32x4 gpv[8], gnv[8];
#pragma unroll
    for (int i = 0; i < 8; ++i) {
        gpv[i] = gpost ? *(const f32x4*)(gpost + (i * 64 + lane) * 4) : (f32x4){0.f, 0.f, 0.f, 0.f};
        gnv[i] = gnext ? *(const f32x4*)(gnext + (i * 64 + lane) * 4) : (f32x4){0.f, 0.f, 0.f, 0.f};
    }
    for (int row = row_lo + (spread ? wblk + wid * nwblk : wblk * 8 + wid); row < row_hi; row += nwblk * 8) {
        f32x4 xv[8];
        if (xb) {
#pragma unroll
            for (int i = 0; i < 8; ++i) { const u32x2 b = *(const u32x2*)(xb + (size_t)row * DM + (i * 64 + lane) * 4); xv[i][0] = bflo(b[0]); xv[i][1] = bfhi(b[0]); xv[i][2] = bflo(b[1]); xv[i][3] = bfhi(b[1]); }
        } else {
            const float* xi = row < NP ? xin_p + (size_t)row * DM : xin_s + (size_t)(row - NP) * DM;
#pragma unroll
            for (int i = 0; i < 8; ++i) xv[i] = *(const f32x4*)(xi + (i * 64 + lane) * 4);
        }
        if (raw) {
            f32x4 rv[8]; float ss = 0.f;
            if (row < NP) {
#pragma unroll
                for (int i = 0; i < 8; ++i) { const u32x2 rb = *(const u32x2*)(raw + (size_t)row * DM + (i * 64 + lane) * 4); rv[i][0] = bflo(rb[0]); rv[i][1] = bfhi(rb[0]); rv[i][2] = bflo(rb[1]); rv[i][3] = bfhi(rb[1]); }
            } else {
                const bf16_t* pr = (const bf16_t*)part + (size_t)(row - NP) * DM + lane * 4;
#pragma unroll
                for (int i = 0; i < 8; ++i) { const u32x2 b = *(const u32x2*)(pr + i * 256); rv[i][0] = bflo(b[0]); rv[i][1] = bfhi(b[0]); rv[i][2] = bflo(b[1]); rv[i][3] = bfhi(b[1]); }
#pragma unroll 4
                for (int s = 1; s < nsplit; ++s) {
                    u32x2 tv[8];
#pragma unroll
                    for (int i = 0; i < 8; ++i) tv[i] = *(const u32x2*)(pr + (size_t)s * 256 * DM + i * 256);
#pragma unroll
                    for (int i = 0; i < 8; ++i) { rv[i][0] += bflo(tv[i][0]); rv[i][1] += bfhi(tv[i][0]); rv[i][2] += bflo(tv[i][1]); rv[i][3] += bfhi(tv[i][1]); }
                }
            }
#pragma unroll
            for (int i = 0; i < 8; ++i) ss += rv[i][0] * rv[i][0] + rv[i][1] * rv[i][1] + rv[i][2] * rv[i][2] + rv[i][3] * rv[i][3];
            ss = wave_sum(ss); const float rs = rsqrtf(ss * (1.0f / DM) + EPS);
#pragma unroll
            for (int i = 0; i < 8; ++i) xv[i] += rv[i] * rs * gpv[i];
            if (yb) {
#pragma unroll
                for (int i = 0; i < 8; ++i) { u32x2 pk; pk[0] = pk2(xv[i][0], xv[i][1]); pk[1] = pk2(xv[i][2], xv[i][3]); *(u32x2*)(yb + (size_t)row * DM + (i * 64 + lane) * 4) = pk; }
            } else {
                float* yo = row < NP ? yout_p + (size_t)row * DM : yout_s + (size_t)(row - NP) * DM;
#pragma unroll
                for (int i = 0; i < 8; ++i) *(f32x4*)(yo + (i * 64 + lane) * 4) = xv[i];
            }
        }
        if (gnext) {
            float ss = 0.f;
#pragma unroll
            for (int i = 0; i < 8; ++i) ss += xv[i][0] * xv[i][0] + xv[i][1] * xv[i][1] + xv[i][2] * xv[i][2] + xv[i][3] * xv[i][3];
            ss = wave_sum(ss); const float rs = rsqrtf(ss * (1.0f / DM) + EPS);
#pragma unroll
            for (int i = 0; i < 8; ++i) {
                const f32x4 hv = xv[i] * rs * gnv[i];
                u32x2 pk; pk[0] = pk2(hv[0], hv[1]); pk[1] = pk2(hv[2], hv[3]);
                *(u32x2*)(H + (size_t)row * DM + (i * 64 + lane) * 4) = pk;
            }
        }
    }
}

constexpr int RG_IN = 18;
struct InOrder {
    pg8::StaticOrder so; int G, c;
    DI void init(int G_, int c_) { so.init(MT, 21 * 256, G_, c_); G = G_; c = c_; }
    DI bool next(int i, pg8::Unit& u) const {
        const int L = i * G + c;
        if (L < 693) { so.next(i, u); if (u.pn >= 8) u.pn += 4; return true; }
        const int L2 = L - 693;
        if (L2 < RG_IN * 4) { u.pm = L2 >> 2; u.pn = 8 + (L2 & 3); return true; }
        return false;
    }
    DI void a_ready(const pg8::Unit&) const {}
    DI void done(const pg8::Unit&) const {}
};

struct ConvTile { const float* src; bf16_t* dst; int ld, Kd, k0, n0, sc; };
DI ConvTile conv_tile(const Params& p, int t, int lane) {
    ConvTile c; const int l = t >= 3104 ? 1 : 0; int u = t - l * 3104; int nn;
    if (u < 800) { c.k0 = (u / 25) * 64; c.n0 = (u % 25) * 256; c.src = p.w_in + (size_t)l * DM * 6168; c.ld = 6168; c.dst = p.WinT + (size_t)l * NIN * DM; c.Kd = DM; nn = c.n0 + 4 * lane;
        c.sc = nn < 2048 ? nn : nn < 6144 ? nn + 16 : nn < 6160 ? nn - 4096 : nn < 6168 ? nn : -1; }
    else if ((u -= 800) < 256) { c.k0 = (u >> 3) * 64; c.n0 = (u & 7) * 256; c.src = p.w_out + (size_t)l * DM * DM; c.ld = DM; c.dst = p.WoutT + (size_t)l * DM * DM; c.Kd = DM; c.sc = c.n0 + 4 * lane; }
    else if ((u -= 256) < 1024) { c.k0 = (u >> 5) * 64; c.n0 = (u & 31) * 256; c.src = p.w_up + (size_t)l * DM * DFF; c.ld = DFF; c.dst = p.WupT + (size_t)l * DFF * DM; c.Kd = DM; c.sc = c.n0 + 4 * lane; }
    else { u -= 1024; c.k0 = (u >> 3) * 64; c.n0 = (u & 7) * 256; c.src = p.w_down + (size_t)l * DFF * DM; c.ld = DM; c.dst = p.WdownT + (size_t)l * DM * DFF; c.Kd = DFF; c.sc = c.n0 + 4 * lane; }
    return c;
}
DI void convert_weights(const Params& p, char* shm, int t_begin, int t_end, int t_stride) {
    const int tid = tid_opaque(), lane = tid & 63, wv = tid >> 6;
    int t = t_begin;
    if (t >= t_end) return;
    ConvTile c = conv_tile(p, t, lane);
    f32x4 v[8];
#pragma unroll
    for (int e = 0; e < 8; ++e) { v[e][0] = v[e][1] = v[e][2] = v[e][3] = 0.f; if (c.sc >= 0) v[e] = *(const f32x4*)(c.src + (size_t)(c.k0 + 8 * wv + e) * c.ld + c.sc); }
    for (;;) {
#pragma unroll
        for (int j = 0; j < 4; ++j) {
            u32x4 pk; pk[0] = pk2(v[0][j], v[1][j]); pk[1] = pk2(v[2][j], v[3][j]); pk[2] = pk2(v[4][j], v[5][j]); pk[3] = pk2(v[6][j], v[7][j]);
            *(u32x4*)(shm + (4 * lane + j) * 144 + wv * 16) = pk;
        }
        const ConvTile cur = c;
        const int tn = t + t_stride; const bool more = tn < t_end;
        if (more) { c = conv_tile(p, tn, lane);
#pragma unroll
            for (int e = 0; e < 8; ++e) { v[e][0] = v[e][1] = v[e][2] = v[e][3] = 0.f; if (c.sc >= 0) v[e] = *(const f32x4*)(c.src + (size_t)(c.k0 + 8 * wv + e) * c.ld + c.sc); } }
        __syncthreads();
#pragma unroll
        for (int i = 0; i < 4; ++i) {
            const int q = tid + 512 * i, row = q >> 3, ch = q & 7;
            *(u32x4*)(cur.dst + (size_t)(cur.n0 + row) * cur.Kd + cur.k0 + ch * 8) = *(const u32x4*)(shm + row * 144 + ch * 16);
        }
        __syncthreads();
        if (!more) break;
        t = tn;
    }
}

DI void phase0(const Params& p, char* shm) {
    if (blockIdx.x == 0 && tid_opaque() < 32) p.ctr[tid_opaque()] = 0u;
    convert_weights(p, shm, (int)blockIdx.x, 6208, (int)gridDim.x);
    norm_rows(p.x_prompt, p.x_sample, nullptr, nullptr, 0, nullptr, p.g_mix_pre, nullptr, nullptr, p.H, 0, MT, (int)blockIdx.x, (int)gridDim.x);
}

template <class F>
DI void block_cumsum(int n, F load, float* cs, float* wt) {
    const int tid = tid_opaque(), lane = tid & 63, wid = tid >> 6;
    float v[5]; float s = 0.f;
#pragma unroll
    for (int j = 0; j < 5; ++j) { const int idx = tid * 5 + j; v[j] = idx < n ? load(idx) : 0.f; s += v[j]; }
    float inc = s;
#pragma unroll
    for (int o = 1; o < 64; o <<= 1) { const float t = __shfl_up(inc, o); if (lane >= o) inc += t; }
    if (lane == 63) wt[wid] = inc;
    __syncthreads();
    float run = inc - s;
    for (int w = 0; w < wid; ++w) run += wt[w];
#pragma unroll
    for (int j = 0; j < 5; ++j) { const int idx = tid * 5 + j; run += v[j]; if (idx < n) cs[idx] = run * LOG2E; }
    __syncthreads();
}

template <int NKT>
DI void fox_tile(const bf16_t* Ks, int ldk, const bf16_t* Vt, int ldv, const float* csl, int kpos0, int qpos, float cql,
                 const bf16x8 (&qf)[8], f32x16 (&o)[4], float& m, float& l, int r, int hh, bool need_mask) {
    constexpr float SC2 = 0.08838834764831845f * LOG2E;
    f32x16 x[NKT];
#pragma unroll
    for (int t2 = 0; t2 < NKT; ++t2) {
#pragma unroll
        for (int i = 0; i < 16; ++i) x[t2][i] = 0.f;
#pragma unroll
        for (int ks = 0; ks < 8; ++ks) { const bf16x8 a = *(const bf16x8*)(Ks + (t2 * 32 + r) * ldk + 16 * ks + 8 * hh); x[t2] = MFMA32(a, qf[ks], x[t2]); }
    }
    float mx = -1e30f;
#pragma unroll
    for (int t2 = 0; t2 < NKT; ++t2)
#pragma unroll
        for (int i = 0; i < 16; ++i) {
            const int kl = t2 * 32 + crow(i, hh);
            const f32x4 c4 = *(const f32x4*)(csl + t2 * 32 + 8 * (i >> 2) + 4 * hh);
            float v = fmaf(x[t2][i], SC2, cql - c4[i & 3]);
            if (need_mask) v = (kpos0 + kl <= qpos) ? v : -1e30f;
            x[t2][i] = v; mx = fmaxf(mx, v);
        }
    mx = fmaxf(mx, __shfl_xor(mx, 32));
    const float mn = fmaxf(m, mx), alpha = __builtin_amdgcn_exp2f(m - mn);
    m = mn;
    float ls = 0.f;
#pragma unroll
    for (int t2 = 0; t2 < NKT; ++t2)
#pragma unroll
        for (int i = 0; i < 16; ++i) { const float pv = __builtin_amdgcn_exp2f(x[t2][i] - mn); x[t2][i] = pv; ls += pv; }
    l = l * alpha + ls;
    if (__builtin_amdgcn_ballot_w64(alpha != 1.0f) != 0ull) {
#pragma unroll
        for (int dt = 0; dt < 4; ++dt)
#pragma unroll
            for (int i = 0; i < 16; ++i) o[dt][i] *= alpha;
    }
#pragma unroll
    for (int t2 = 0; t2 < NKT; ++t2)
#pragma unroll
        for (int s = 0; s < 2; ++s) {
            u32x4 pp; pp[0] = pk2(x[t2][8 * s + 0], x[t2][8 * s + 1]); pp[1] = pk2(x[t2][8 * s + 2], x[t2][8 * s + 3]);
            pp[2] = pk2(x[t2][8 * s + 4], x[t2][8 * s + 5]); pp[3] = pk2(x[t2][8 * s + 6], x[t2][8 * s + 7]);
            const bf16x8 pf = __builtin_bit_cast(bf16x8, pp);
#pragma unroll
            for (int dt = 0; dt < 4; ++dt) {
                const bf16_t* vp = Vt + (dt * 32 + r) * ldv + t2 * 32 + 16 * s + 4 * hh;
                const s16x4 lo = *(const s16x4*)vp, hi = *(const s16x4*)(vp + 8);
                const bf16x8 a = __builtin_shufflevector(lo, hi, 0, 1, 2, 3, 4, 5, 6, 7);
                o[dt] = MFMA32(a, pf, o[dt]);
            }
        }
}

DI void fox_prompt_item(const Params& p, int l, int b, int h, int qb, char* shm) {
    bf16_t* Ks = (bf16_t*)shm; bf16_t* Vt = (bf16_t*)(shm + 17408); float* cs = (float*)(shm + 143360); float* wt = (float*)(shm + 151680);
    const int tid = tid_opaque(), wid = tid >> 6, lane = tid & 63, r = lane & 31, hh = lane >> 5;
    const int nkeys = (qb + 1) * 256;
    const float* lf = p.EX + ((size_t)b * 2048) * 32 + 16 + h; const float fb = p.b_fox_f[l * 8 + h];
    block_cumsum(nkeys, [&](int i) { return logsig(lf[(size_t)i * 32] + fb); }, cs, wt);
    const int qpos = qb * 256 + wid * 32 + r; const size_t qrow = (size_t)b * 2048 + qpos;
    bf16x8 qf[8];
    { const bf16_t* zq = p.Z + qrow * NZ + 3072 + h * 128;
#pragma unroll
      for (int ks = 0; ks < 8; ++ks) qf[ks] = *(const bf16x8*)(zq + 16 * ks + 8 * hh); }
    const float cql = cs[qpos];
    f32x16 o[4];
#pragma unroll
    for (int dt = 0; dt < 4; ++dt)
#pragma unroll
        for (int i = 0; i < 16; ++i) o[dt][i] = 0.f;
    float m = -1e30f, lsum = 0.f;
    const int nt = (qb + 1) * 4;
    const bf16_t* zk = p.Z + (size_t)b * 2048 * NZ + 4096 + h * 128; const bf16_t* zv = zk + 1024;
    int krow_[2], kc8[2], vrow[2], vc8[2];
#pragma unroll
    for (int i = 0; i < 2; ++i) { const int q = tid + 512 * i; krow_[i] = q >> 4; kc8[i] = (q & 15) * 8; vrow[i] = 2 * ((wid & 1) * 16 + (lane & 15)) + i; vc8[i] = ((wid >> 1) * 4 + (lane >> 4)) * 8; }
    u32x4 kreg[2], vreg[2];
#pragma unroll
    for (int i = 0; i < 2; ++i) { kreg[i] = *(const u32x4*)(zk + (size_t)((nt - 1) * 64 + krow_[i]) * NZ + kc8[i]); vreg[i] = *(const u32x4*)(zv + (size_t)((nt - 1) * 64 + vrow[i]) * NZ + vc8[i]); }
    const int qmaxw = qb * 256 + wid * 32 + 31, qminw = qb * 256 + wid * 32;
    for (int kt = nt - 1; kt >= 0; --kt) {
        __syncthreads();
#pragma unroll
        for (int i = 0; i < 2; ++i) {
            *(u32x4*)(Ks + krow_[i] * 136 + kc8[i]) = kreg[i];
        }
#pragma unroll
        for (int e = 0; e < 4; ++e) { const unsigned a_ = vreg[0][e], b_ = vreg[1][e]; unsigned* vd = (unsigned*)Vt;
            vd[((vc8[0] + 2 * e) * 68 + vrow[0]) >> 1] = (a_ & 0xffffu) | (b_ << 16); vd[((vc8[0] + 2 * e + 1) * 68 + vrow[0]) >> 1] = (a_ >> 16) | (b_ & 0xffff0000u); }
        __syncthreads();
        if (kt > 0) {
#pragma unroll
            for (int i = 0; i < 2; ++i) { kreg[i] = *(const u32x4*)(zk + (size_t)((kt - 1) * 64 + krow_[i]) * NZ + kc8[i]); vreg[i] = *(const u32x4*)(zv + (size_t)((kt - 1) * 64 + vrow[i]) * NZ + vc8[i]); }
        }
        if (kt * 64 <= qmaxw) fox_tile<2>(Ks, 136, Vt, 68, cs + kt * 64, kt * 64, qpos, cql, qf, o, m, lsum, r, hh, kt * 64 + 63 > qminw);
    }
    const float lt = lsum + __shfl_xor(lsum, 32); const float inv = 1.0f / lt;
    bf16_t* mo = p.MRG + qrow * DM + 1024 + h * 128;
#pragma unroll
    for (int dt = 0; dt < 4; ++dt)
#pragma unroll
        for (int g = 0; g < 4; ++g) {
            u32x2 pk; pk[0] = pk2(o[dt][4 * g] * inv, o[dt][4 * g + 1] * inv); pk[1] = pk2(o[dt][4 * g + 2] * inv, o[dt][4 * g + 3] * inv);
            *(u32x2*)(mo + dt * 32 + 8 * g + 4 * hh) = pk;
        }
}

DI float logsig_fast(float x) { return fminf(x, 0.f) - 0.6931471805599453f * __builtin_amdgcn_logf(1.0f + __builtin_amdgcn_exp2f(-fabsf(x) * LOG2E)); }
DI float exp_fast(float x) { return __builtin_amdgcn_exp2f(x * LOG2E); }

DI void gla_a_item(const Params& p, int l, int it, char* shm) {
    bf16_t* Qi = (bf16_t*)shm; bf16_t* Ki = (bf16_t*)(shm + 17408); bf16_t* Ket = (bf16_t*)(shm + 34816); bf16_t* At = (bf16_t*)(shm + 53248);
    float* dec = (float*)(shm + 62464); float* tot = (float*)(shm + 62976); bf16_t* Vt = (bf16_t*)(shm + 65024);
    float* glr = (float*)(shm + 101888); bf16_t* Qraw = (bf16_t*)(shm + 105984); bf16_t* Kraw = (bf16_t*)(shm + 122368);
    const int tid = tid_opaque(), wid = tid >> 6, lane = tid & 63, r = lane & 31, hh = lane >> 5;
    const int grp = it >= 512 ? 1 : 0;
    const int h = grp ? (it & 3) : ((it >> 5) & 3);
    const int nvalid = grp ? 32 : 64;
    const size_t rowc = grp ? (size_t)NP + (size_t)((it - 512) >> 2) * 32 : (size_t)(it >> 7) * 2048 + (size_t)(it & 31) * 64;
    const int d = tid & 127, sg = tid >> 7;
    float w2[16];
#pragma unroll
    for (int k = 0; k < 16; ++k) w2[k] = p.w_gate_up[((size_t)l * 16 + k) * 512 + h * 128 + d];
    const float bias = p.b_gate[(size_t)l * 512 + h * 128 + d];
    if (tid < 256) {
        const int s = tid >> 2, part = tid & 3; f32x4 v; v[0] = v[1] = v[2] = v[3] = 0.f;
        if (s < nvalid) v = *(const f32x4*)(p.EX + (rowc + s) * 32 + part * 4);
        *(f32x4*)(glr + s * 16 + part * 4) = v;
    }
#pragma unroll
    for (int i = 0; i < 2; ++i) {
        const int q = tid + 512 * i, row = q >> 4, c8 = (q & 15) * 8;
        u32x4 qv, kv; qv[0] = qv[1] = qv[2] = qv[3] = 0u; kv = qv;
        if (row < nvalid) { const bf16_t* zr = p.Z + (rowc + row) * NZ + h * 128 + c8; qv = *(const u32x4*)zr; kv = *(const u32x4*)(zr + 512); }
        *(u32x4*)(Qraw + row * 128 + c8) = qv; *(u32x4*)(Kraw + row * 128 + c8) = kv;
    }
    __syncthreads();
    float gv[16]; float cum = 0.f;
#pragma unroll
    for (int i = 0; i < 16; ++i) {
        const int s = sg * 16 + i; float gl = 0.f;
        if (s < nvalid) {
            const float* e = glr + s * 16; float x = bias;
#pragma unroll
            for (int k4 = 0; k4 < 4; ++k4) { const f32x4 ev = *(const f32x4*)(e + 4 * k4); x += ev[0] * w2[4 * k4] + ev[1] * w2[4 * k4 + 1] + ev[2] * w2[4 * k4 + 2] + ev[3] * w2[4 * k4 + 3]; }
            gl = logsig_fast(x) * 0.0625f;
        }
        cum += gl; gv[i] = cum;
    }
    tot[sg * 128 + d] = cum;
#pragma unroll
    for (int i = 0; i < 2; ++i) {
        const int q = tid + 512 * i, wv = q >> 6, ln = q & 63, pr = (wv & 1) * 16 + (ln & 15), pc = (wv >> 1) * 4 + (ln >> 4);
        u32x4 va, vb; va[0] = va[1] = va[2] = va[3] = 0u; vb = va;
        if (2 * pr < nvalid) { const bf16_t* zr = p.Z + (rowc + 2 * pr) * NZ + 1024 + h * 256 + pc * 8; va = *(const u32x4*)zr; vb = *(const u32x4*)(zr + NZ); }
        unsigned* vd = (unsigned*)Vt;
#pragma unroll
        for (int e = 0; e < 4; ++e) {
            vd[((pc * 8 + 2 * e) * 72 + 2 * pr) >> 1] = (va[e] & 0xffffu) | (vb[e] << 16);
            vd[((pc * 8 + 2 * e + 1) * 72 + 2 * pr) >> 1] = (va[e] >> 16) | (vb[e] & 0xffff0000u);
        }
    }
    __syncthreads();
    float off = 0.f;
    for (int g = 0; g < sg; ++g) off += tot[g * 128 + d];
    const float blast = tot[d] + tot[128 + d] + tot[256 + d] + tot[384 + d];
    {
        float kev[16];
#pragma unroll
        for (int i = 0; i < 16; ++i) {
            const int s = sg * 16 + i; const float bb = off + gv[i]; float q = 0.f, k = 0.f;
            q = bf2f(Qraw[s * 128 + d]); k = bf2f(Kraw[s * 128 + d]);
            const bf16_t qi = f2bf(q * exp_fast(bb));
            Qi[s * 136 + d] = qi; Ki[s * 136 + d] = f2bf(k * exp_fast(-bb)); kev[i] = k * exp_fast(blast - bb);
        }
        u32x4 p0, p1;
        p0[0] = pk2(kev[0], kev[1]); p0[1] = pk2(kev[2], kev[3]); p0[2] = pk2(kev[4], kev[5]); p0[3] = pk2(kev[6], kev[7]);
        p1[0] = pk2(kev[8], kev[9]); p1[1] = pk2(kev[10], kev[11]); p1[2] = pk2(kev[12], kev[13]); p1[3] = pk2(kev[14], kev[15]);
        *(u32x4*)(Ket + d * 72 + sg * 16) = p0; *(u32x4*)(Ket + d * 72 + sg * 16 + 8) = p1;
        if (sg == 0) p.DEC[(size_t)it * 128 + d] = exp_fast(blast);
    }
    __syncthreads();
#pragma unroll
    for (int i = 0; i < 2; ++i) {
        const int q = tid + 512 * i, row = q >> 4, c8 = (q & 15) * 8;
        if (row < nvalid) *(u32x4*)(p.QI + (rowc + row) * 512 + h * 128 + c8) = *(const u32x4*)(Qi + row * 136 + c8);
    }
    if (wid < 3) {
        const int si = wid == 2 ? 1 : 0, ci = wid >= 1 ? 1 : 0;
        f32x16 x;
#pragma unroll
        for (int i = 0; i < 16; ++i) x[i] = 0.f;
#pragma unroll
        for (int ks = 0; ks < 8; ++ks) {
            const bf16x8 a = *(const bf16x8*)(Ki + (si * 32 + r) * 136 + 16 * ks + 8 * hh);
            const bf16x8 bq = *(const bf16x8*)(Qi + (ci * 32 + r) * 136 + 16 * ks + 8 * hh);
            x = MFMA32(a, bq, x);
        }
        const int c = ci * 32 + r;
#pragma unroll
        for (int g = 0; g < 4; ++g) {
            float v[4];
#pragma unroll
            for (int e = 0; e < 4; ++e) { const int s = si * 32 + 8 * g + 4 * hh + e; v[e] = s <= c ? x[4 * g + e] : 0.f; }
            u32x2 pk; pk[0] = pk2(v[0], v[1]); pk[1] = pk2(v[2], v[3]);
            *(u32x2*)(At + c * 72 + si * 32 + 8 * g + 4 * hh) = pk;
        }
    }
    __syncthreads();
    {
        bf16x8 av[4];
#pragma unroll
        for (int ks = 0; ks < 4; ++ks) av[ks] = *(const bf16x8*)(Vt + (wid * 32 + r) * 72 + 16 * ks + 8 * hh);
#pragma unroll
        for (int ci = 0; ci < 2; ++ci) {
            if (ci * 32 < nvalid) {
                f32x16 oa;
#pragma unroll
                for (int i = 0; i < 16; ++i) oa[i] = 0.f;
#pragma unroll
                for (int ks = 0; ks < 4; ++ks) {
                    if (ks < (ci ? 4 : 2)) { const bf16x8 bq = *(const bf16x8*)(At + (ci * 32 + r) * 72 + 16 * ks + 8 * hh); oa = MFMA32(av[ks], bq, oa); }
                }
                bf16_t* og = (bf16_t*)p.OG + (rowc + ci * 32 + r) * 1024 + h * 256 + wid * 32 + 4 * hh;
#pragma unroll
                for (int g = 0; g < 4; ++g) { u32x2 pk; pk[0] = pk2(oa[4 * g], oa[4 * g + 1]); pk[1] = pk2(oa[4 * g + 2], oa[4 * g + 3]); *(u32x2*)(og + 8 * g) = pk; }
            }
        }
        bf16_t* kvt = (bf16_t*)p.KVT + (size_t)it * 32768;
#pragma unroll
        for (int di = 0; di < 4; ++di) {
            f32x16 acc;
#pragma unroll
            for (int i = 0; i < 16; ++i) acc[i] = 0.f;
#pragma unroll
            for (int ks = 0; ks < 4; ++ks) { const bf16x8 bq = *(const bf16x8*)(Ket + (di * 32 + r) * 72 + 16 * ks + 8 * hh); acc = MFMA32(bq, av[ks], acc); }
#pragma unroll
            for (int g = 0; g < 4; ++g) { u32x2 pk; pk[0] = pk2(acc[4 * g], acc[4 * g + 1]); pk[1] = pk2(acc[4 * g + 2], acc[4 * g + 3]); *(u32x2*)(kvt + (wid * 32 + r) * 128 + di * 32 + 8 * g + 4 * hh) = pk; }
        }
    }
}

DI void gla_scan(const Params& p, int l) {
    const int tid = tid_opaque();
    for (int idx = blockIdx.x * 512 + tid; idx < MT * 8; idx += gridDim.x * 512) {
        const int row = idx >> 3, hd = idx & 7; const float lf = logsig(p.EX[(size_t)row * 32 + 16 + hd] + p.b_fox_f[l * 8 + hd]);
        if (row < NP) p.out[O_LFP + ((size_t)l * NP + row) * 8 + hd] = lf; else p.out[O_LFS + ((size_t)l * NS + row - NP) * 8 + hd] = lf;
    }
    for (int t = blockIdx.x; t < 768; t += gridDim.x) {
        const int grp = t >= 256 ? 1 : 0, u = grp ? t - 256 : t, seq = u >> 4, vt = u & 15;
        const int nch = grp ? 1 : 32, item0 = grp ? 512 + seq : seq * 32;
        const int v = vt * 16 + (tid & 15), d0 = (tid >> 4) * 4;
        float S[4];
        if (grp) {
            const float* sin = p.state_gla + (((size_t)l * 32 + seq) * 128 + d0) * 256 + v;
#pragma unroll
            for (int j = 0; j < 4; ++j) S[j] = sin[(size_t)j * 256];
        } else {
#pragma unroll
            for (int j = 0; j < 4; ++j) S[j] = 0.f;
        }
#pragma unroll 8
        for (int n = 0; n < nch; ++n) {
            const size_t it = (size_t)(item0 + n);
            u32x2 pk; pk[0] = pk2(S[0], S[1]); pk[1] = pk2(S[2], S[3]);
            *(u32x2*)(p.SS + it * 32768 + (size_t)v * 128 + d0) = pk;
            const u32x2 kb = *(const u32x2*)((const bf16_t*)p.KVT + it * 32768 + (size_t)v * 128 + d0); const f32x4 c0 = *(const f32x4*)(p.DEC + it * 128 + d0);
            f32x4 k0; k0[0] = bflo(kb[0]); k0[1] = bfhi(kb[0]); k0[2] = bflo(kb[1]); k0[3] = bfhi(kb[1]);
#pragma unroll
            for (int j = 0; j < 4; ++j) S[j] = c0[j] * S[j] + k0[j];
        }
        float* so = (grp ? p.out + O_STS + (((size_t)l * 32 + seq) * 128 + d0) * 256 : p.out + O_STP + (((size_t)l * 16 + seq) * 128 + d0) * 256) + v;
#pragma unroll
        for (int j = 0; j < 4; ++j) so[(size_t)j * 256] = S[j];
    }
}

DI void gla_c_stage(const Params& p, int l, char* shm) {
    const int tid = tid_opaque(), wid = tid >> 6, lane = tid & 63, r = lane & 31, hh = lane >> 5;
    for (int wt = wid * (int)gridDim.x + (int)blockIdx.x; wt < 1088; wt += 8 * (int)gridDim.x) {
        const int it = wt >> 1, ci = wt & 1;
        const int grp = it >= 512 ? 1 : 0;
        if (grp && ci) continue;
        const int h = grp ? (it & 3) : ((it >> 5) & 3);
        const size_t rowc = grp ? (size_t)NP + (size_t)((it - 512) >> 2) * 32 : (size_t)(it >> 7) * 2048 + (size_t)(it & 31) * 64;
        const size_t row = rowc + ci * 32 + r;
        bf16x8 bq[8];
#pragma unroll
        for (int ks = 0; ks < 8; ++ks) bq[ks] = *(const bf16x8*)(p.QI + row * 512 + h * 128 + 16 * ks + 8 * hh);
        f32x16 acc[8];
        float ss = 0.f;
#pragma unroll
        for (int vt = 0; vt < 8; ++vt) {
            const bf16_t* og = (const bf16_t*)p.OG + row * 1024 + h * 256 + vt * 32 + 4 * hh;
#pragma unroll
            for (int g = 0; g < 4; ++g) { const u32x2 v = *(const u32x2*)(og + 8 * g); acc[vt][4 * g] = bflo(v[0]); acc[vt][4 * g + 1] = bfhi(v[0]); acc[vt][4 * g + 2] = bflo(v[1]); acc[vt][4 * g + 3] = bfhi(v[1]); }
            const bf16_t* ssp = p.SS + (size_t)it * 32768 + (size_t)(vt * 32 + r) * 128 + 8 * hh;
#pragma unroll
            for (int ks = 0; ks < 8; ++ks) { const bf16x8 a = *(const bf16x8*)(ssp + 16 * ks); acc[vt] = MFMA32(a, bq[ks], acc[vt]); }
#pragma unroll
            for (int i = 0; i < 16; ++i) ss += acc[vt][i] * acc[vt][i];
        }
        ss += __shfl_xor(ss, 32);
        const float rs = rsqrtf(ss * (1.0f / 256.0f) + EPS);
#pragma unroll
        for (int vt = 0; vt < 8; ++vt) {
            const int vc = h * 256 + vt * 32 + 4 * hh;
#pragma unroll
            for (int g = 0; g < 4; ++g) {
                const f32x4 gn = *(const f32x4*)(p.g_onorm + (size_t)l * 1024 + vc + 8 * g);
                const u32x2 rg = *(const u32x2*)(p.Z + row * NZ + 2048 + vc + 8 * g);
                const float r0 = bflo(rg[0]), r1 = bfhi(rg[0]), r2 = bflo(rg[1]), r3 = bfhi(rg[1]);
                const float o0 = acc[vt][4 * g] * rs * gn[0] * (r0 / (1.0f + exp_fast(-r0))), o1 = acc[vt][4 * g + 1] * rs * gn[1] * (r1 / (1.0f + exp_fast(-r1)));
                const float o2 = acc[vt][4 * g + 2] * rs * gn[2] * (r2 / (1.0f + exp_fast(-r2))), o3 = acc[vt][4 * g + 3] * rs * gn[3] * (r3 / (1.0f + exp_fast(-r3)));
                u32x2 pk; pk[0] = pk2(o0, o1); pk[1] = pk2(o2, o3);
                *(u32x2*)(p.MRG + row * DM + vc + 8 * g) = pk;
            }
        }
    }
}

DI void fox_sample_item(const Params& p, int l, int b, int h, int sp, char* shm) {
    float* cs = (float*)(shm + 143360); float* wt = (float*)(shm + 151680);
    const int tid = tid_opaque(), wid = tid >> 6, lane = tid & 63, r = lane & 31, hh = lane >> 5;
    const float* lfc = p.cache_logf + ((size_t)(l * 8 + b) * 2048) * 8 + h;
    const float* lfn = p.EX + ((size_t)NP + b * 32) * 32 + 16 + h; const float fb = p.b_fox_f[l * 8 + h];
    block_cumsum(2080, [&](int i) { return i < 2048 ? lfc[(size_t)i * 8] : logsig(lfn[(size_t)(i - 2048) * 32] + fb); }, cs, wt);
    const int qpos = 2048 + r; const size_t qrow = (size_t)NP + b * 32 + r;
    bf16x8 qf[8];
    { const bf16_t* zq = p.Z + qrow * NZ + 3072 + h * 128;
#pragma unroll
      for (int ks = 0; ks < 8; ++ks) qf[ks] = *(const bf16x8*)(zq + 16 * ks + 8 * hh); }
    const float cql = cs[qpos];
    f32x16 o[4];
#pragma unroll
    for (int dt = 0; dt < 4; ++dt)
#pragma unroll
        for (int i = 0; i < 16; ++i) o[dt][i] = 0.f;
    float m = -1e30f, lsum = 0.f;
    bf16_t* Ks = (bf16_t*)(shm + wid * 17920); bf16_t* Vt = (bf16_t*)(shm + wid * 17920 + 8704);
    const int jend = sp * 17 + 17 < 65 ? sp * 17 + 17 : 65;
    for (int j = sp * 17 + wid; j < jend; j += 8) {
        const float* srcK = j < 64 ? p.cache_k + (((size_t)(l * 8 + b) * 2048 + (size_t)j * 32) * 8 + h) * 128 : p.out + O_KS + (((size_t)(l * 8 + b) * 32) * 8 + h) * 128;
        const float* srcV = j < 64 ? p.cache_v + (((size_t)(l * 8 + b) * 2048 + (size_t)j * 32) * 8 + h) * 128 : p.out + O_VS + (((size_t)(l * 8 + b) * 32) * 8 + h) * 128;
        {
            const int prow = lane >> 5, pc4 = (lane & 31) * 4;
            f32x4 kr[16], va[4];
#pragma unroll
            for (int i = 0; i < 16; ++i) kr[i] = *(const f32x4*)(srcK + (size_t)(2 * i + prow) * 1024 + pc4);
#pragma unroll
            for (int i = 0; i < 4; ++i) va[i] = *(const f32x4*)(srcV + (size_t)(2 * i + prow) * 1024 + pc4);
#pragma unroll
            for (int i = 0; i < 16; ++i) { u32x2 pk; pk[0] = pk2(kr[i][0], kr[i][1]); pk[1] = pk2(kr[i][2], kr[i][3]); *(u32x2*)(Ks + (2 * i + prow) * 136 + pc4) = pk; }
            asm volatile("" ::: "memory");
            f32x4 vb[12];
#pragma unroll
            for (int i = 0; i < 12; ++i) vb[i] = *(const f32x4*)(srcV + (size_t)(2 * (i + 4) + prow) * 1024 + pc4);
#pragma unroll
            for (int i = 0; i < 4; ++i) {
#pragma unroll
                for (int e = 0; e < 4; ++e) Vt[(pc4 + e) * 36 + 2 * i + prow] = f2bf(va[i][e]);
            }
#pragma unroll
            for (int i = 0; i < 12; ++i) {
#pragma unroll
                for (int e = 0; e < 4; ++e) Vt[(pc4 + e) * 36 + 2 * (i + 4) + prow] = f2bf(vb[i][e]);
            }
        }
        fox_tile<1>(Ks, 136, Vt, 36, cs + j * 32, j * 32, qpos, cql, qf, o, m, lsum, r, hh, j == 64);
    }
    const float lt = lsum + __shfl_xor(lsum, 32);
    __syncthreads();
    float* ml = wt;
    if (hh == 0) { ml[(wid * 32 + r) * 2] = m; ml[(wid * 32 + r) * 2 + 1] = lt; }
    __syncthreads();
    float M = -1e30f;
#pragma unroll
    for (int w = 0; w < 8; ++w) M = fmaxf(M, ml[(w * 32 + r) * 2]);
    float L = 0.f;
#pragma unroll
    for (int w = 0; w < 8; ++w) L += __builtin_amdgcn_exp2f(ml[(w * 32 + r) * 2] - M) * ml[(w * 32 + r) * 2 + 1];
    const float f = __builtin_amdgcn_exp2f(m - M);
    float* ow = (float*)shm + wid * (32 * 132);
#pragma unroll
    for (int dt = 0; dt < 4; ++dt)
#pragma unroll
        for (int g = 0; g < 4; ++g) {
            f32x4 v; v[0] = o[dt][4 * g] * f; v[1] = o[dt][4 * g + 1] * f; v[2] = o[dt][4 * g + 2] * f; v[3] = o[dt][4 * g + 3] * f;
            *(f32x4*)(ow + r * 132 + dt * 32 + 8 * g + 4 * hh) = v;
        }
    const int slot = ((b * 8 + h) * 4 + sp);
    if (wid == 0 && hh == 0) { p.FSML[(size_t)(slot * 32 + r) * 2] = M; p.FSML[(size_t)(slot * 32 + r) * 2 + 1] = L; }
    __syncthreads();
    {
        const int q = tid >> 4, d8 = (tid & 15) * 8; float acc[8];
#pragma unroll
        for (int e = 0; e < 8; ++e) acc[e] = 0.f;
#pragma unroll
        for (int w = 0; w < 8; ++w) {
            const float* src = (const float*)shm + w * (32 * 132) + q * 132 + d8;
            const f32x4 a = *(const f32x4*)src, c = *(const f32x4*)(src + 4);
#pragma unroll
            for (int e = 0; e < 4; ++e) { acc[e] += a[e]; acc[4 + e] += c[e]; }
        }
        float* dst = p.FSO + ((size_t)slot * 32 + q) * 128 + d8;
        f32x4 v0, v1; v0[0] = acc[0]; v0[1] = acc[1]; v0[2] = acc[2]; v0[3] = acc[3]; v1[0] = acc[4]; v1[1] = acc[5]; v1[2] = acc[6]; v1[3] = acc[7];
        *(f32x4*)dst = v0; *(f32x4*)(dst + 4) = v1;
    }
}

DI void fox_sample_combine(const Params& p) {
    for (int idx = blockIdx.x * 512 + tid_opaque(); idx < 64 * 32 * 16; idx += gridDim.x * 512) {
        const int d8 = (idx & 15) * 8, q = (idx >> 4) & 31, bh = idx >> 9;
        float ms[4], ls[4], M = -1e30f;
#pragma unroll
        for (int s = 0; s < 4; ++s) { ms[s] = p.FSML[(size_t)((bh * 4 + s) * 32 + q) * 2]; ls[s] = p.FSML[(size_t)((bh * 4 + s) * 32 + q) * 2 + 1]; M = fmaxf(M, ms[s]); }
        float L = 0.f, acc[8];
#pragma unroll
        for (int e = 0; e < 8; ++e) acc[e] = 0.f;
#pragma unroll
        for (int s = 0; s < 4; ++s) {
            const float w = __builtin_amdgcn_exp2f(ms[s] - M); L += w * ls[s];
            const float* src = p.FSO + ((size_t)(bh * 4 + s) * 32 + q) * 128 + d8;
            const f32x4 a = *(const f32x4*)src, c = *(const f32x4*)(src + 4);
#pragma unroll
            for (int e = 0; e < 4; ++e) { acc[e] += w * a[e]; acc[4 + e] += w * c[e]; }
        }
        const float inv = 1.0f / L;
        u32x4 pk; pk[0] = pk2(acc[0] * inv, acc[1] * inv); pk[1] = pk2(acc[2] * inv, acc[3] * inv); pk[2] = pk2(acc[4] * inv, acc[5] * inv); pk[3] = pk2(acc[6] * inv, acc[7] * inv);
        *(u32x4*)(p.MRG + ((size_t)NP + (bh >> 3) * 32 + q) * DM + 1024 + (bh & 7) * 128 + d8) = pk;
    }
}

DI int pop_item(unsigned* ctr, char* shm) {
    volatile int* sitem = (volatile int*)(shm + LDS_ITEM_OFF);
    __syncthreads();
    if (tid_opaque() == 0) *sitem = (int)atomicAdd(ctr, 1u);
    __syncthreads();
    return *sitem;
}
template <int WHICH>
DI void mixer_phase(const Params& p, int l, char* shm, int coff) {
    if constexpr (WHICH & 1) for (;;) {
        const int j = pop_item(p.ctr + coff + l * 4 + 1, shm);
        if (j >= 256) break;
        fox_prompt_item(p, l, (j & 31) >> 3, j & 7, 7 - (j >> 5), shm);
    }
    if constexpr (WHICH == 7) for (;;) {
        const int j = pop_item(p.ctr + 16 + l, shm);
        if (j >= (33 - RG_IN) * 4) break;
        EpiIn E; E.Z = p.Z; E.EX = p.EX; E.row_base = RG_IN * 256; E.pn_base = 8; E.outk_p = E.outv_p = E.outk_s = E.outv_s = nullptr;
        run_gemm(shm, p.H + (size_t)RG_IN * 256 * DM, p.WinT + (size_t)l * NIN * DM + (size_t)2048 * DM, (33 - RG_IN) * 256, 1024, DM, DM, DM, 1, E, (33 - RG_IN) * 4, j);
    }
    if constexpr (WHICH & 2) for (;;) {
        const int j = pop_item(p.ctr + coff + l * 4 + 2, shm);
        if (j >= 256) break;
        fox_sample_item(p, l, j >> 5, (j >> 2) & 7, j & 3, shm);
    }
    if constexpr (WHICH & 4) for (;;) {
        const int item = pop_item(p.ctr + coff + l * 4 + 0, shm);
        if (item >= 544) break;
        gla_a_item(p, l, item, shm);
    }
}

constexpr int NPHASE = 17;
constexpr int SPLIT_OUT = 8, SPLIT_DOWN = 16;
template <int S>
DI void run_stage(const Params& p, int l, char* shm) {
    float* yp = p.out + O_YP; float* ys = p.out + O_YS;
    if constexpr (S == 8) { phase0(p, shm); }
    if constexpr (S == 0) { EpiIn E; E.Z = p.Z; E.EX = p.EX; E.row_base = 0; E.pn_base = 0; E.outk_p = p.out + O_KP + (size_t)l * NP * 1024; E.outv_p = p.out + O_VP + (size_t)l * NP * 1024;
              E.outk_s = p.out + O_KS + (size_t)l * NS * 1024; E.outv_s = p.out + O_VS + (size_t)l * NS * 1024;
              pg8::Gemm g; g.A = p.H; g.Bt = p.WinT + (size_t)l * NIN * DM; g.M = MT; g.N = NIN; g.K = DM; g.lda = DM; g.ldb = DM; g.nct = NIN / 256; g.ksub = DM;
              InOrder S0; S0.init((int)gridDim.x, (int)blockIdx.x);
              pg8::gemm_phase<EpiIn, InOrder, false>((PG8_LAS unsigned char*)shm, g, S0, E, nullptr); }
    if constexpr (S == 1) mixer_phase<7>(p, l, shm, 0);
#if defined(PROBE) && PROBE >= 3 && PROBE <= 5
    if constexpr (S == 9) mixer_phase<(PROBE == 3 ? 1 : PROBE == 4 ? 2 : 4)>(p, l, shm, 8);
#endif
    if constexpr (S == 12) mixer_phase<7>(p, l, shm, 8);
    if constexpr (S == 2) { fox_sample_combine(p); gla_scan(p, l); }
    if constexpr (S == 10) gla_c_stage(p, l, shm);
    if constexpr (S == 3) { EpiRaw E; E.C = p.RAW; run_gemm(shm, p.MRG, p.WoutT + (size_t)l * DM * DM, NP, DM, DM, DM, DM, 1, E);
              EpiPart EP; EP.P = (bf16_t*)p.PART; run_gemm(shm, p.MRG + (size_t)NP * DM, p.WoutT + (size_t)l * DM * DM, NS, DM, DM / SPLIT_OUT, DM, DM, SPLIT_OUT, EP); }
    if constexpr (S == 14)
        norm_rows(l == 0 ? p.x_prompt : yp, l == 0 ? p.x_sample : ys, p.RAW, p.PART, SPLIT_OUT, p.g_mix_post + (size_t)l * DM, p.g_mlp_pre + (size_t)l * DM, yp, ys, p.H, NP, MT, (int)blockIdx.x, (int)gridDim.x, true, l == 0 ? nullptr : p.YB, p.YB);
    if constexpr (S == 4) {
        const int ng = (int)gridDim.x - 32;
        if ((int)blockIdx.x >= ng) { EpiUp E; E.U = p.U + (size_t)NP * DFF; run_gemm(shm, p.H + (size_t)NP * DM, p.WupT + (size_t)l * DFF * DM, NS, DFF, DM, DM, DM, 1, E, 32, (int)blockIdx.x - ng); }
        else norm_rows(l == 0 ? p.x_prompt : yp, l == 0 ? p.x_sample : ys, p.RAW, p.PART, SPLIT_OUT, p.g_mix_post + (size_t)l * DM, p.g_mlp_pre + (size_t)l * DM, yp, ys, p.H, 0, NP, (int)blockIdx.x, ng, false, l == 0 ? nullptr : p.YB, p.YB);
    }
    if constexpr (S == 5) { EpiUp E; E.U = p.U; run_gemm(shm, p.H, p.WupT + (size_t)l * DFF * DM, NP, DFF, DM, DM, DM, 1, E); }
    if constexpr (S == 6) { EpiRaw E; E.C = p.RAW; run_gemm(shm, p.U, p.WdownT + (size_t)l * DM * DFF, NP, DM, DFF, DFF, DFF, 1, E);
              EpiPart EP; EP.P = (bf16_t*)p.PART; run_gemm(shm, p.U + (size_t)NP * DFF, p.WdownT + (size_t)l * DM * DFF, NS, DM, DFF / SPLIT_DOWN, DFF, DFF, SPLIT_DOWN, EP); }
    if constexpr (S == 7) {
        const float* gn = l + 1 < 2 ? p.g_mix_pre + (size_t)(l + 1) * DM : nullptr;
        norm_rows(yp, ys, p.RAW, p.PART, SPLIT_DOWN, p.g_mlp_post + (size_t)l * DM, gn, yp, ys, p.H, NP, MT, (int)blockIdx.x, (int)gridDim.x, true, p.YB, l + 1 < 2 ? p.YB : nullptr);
        norm_rows(yp, ys, p.RAW, p.PART, SPLIT_DOWN, p.g_mlp_post + (size_t)l * DM, gn, yp, ys, p.H, 0, NP, (int)blockIdx.x, (int)gridDim.x, false, p.YB, l + 1 < 2 ? p.YB : nullptr);
    }
}

#if MEGA
DI Params load_params() {
    Params r{};
#if defined(__HIP_DEVICE_COMPILE__)
    const __attribute__((address_space(4))) unsigned long long* kp = (const __attribute__((address_space(4))) unsigned long long*)__builtin_amdgcn_kernarg_segment_ptr();
    asm volatile("" : "+s"(kp));
    unsigned long long* d = (unsigned long long*)&r;
#pragma unroll
    for (int i = 0; i < (int)(sizeof(Params) / 8); ++i) d[i] = kp[i];
#endif
    return r;
}
__global__ void __launch_bounds__(512, 2) k_mega(Params p_unused) {
    extern __shared__ __attribute__((aligned(16))) char shm[];
    cg::grid_group grid = cg::this_grid();
    volatile LAS unsigned* st = (volatile LAS unsigned*)(shm + LDS_ITEM_OFF + 16);
    if (threadIdx.x < 2) st[threadIdx.x] = 0u;
    __syncthreads();
    XcdBarrier bar;
    { const Params q = load_params(); bar = xcd_barrier_post(q.bar, st); }
#define STAGE(S, l) { const Params q = load_params(); run_stage<S>(q, l, shm); }
#if PROBE == 11
#define SYNC() xcd_barrier(bar); xcd_barrier(bar);
#else
#define SYNC() xcd_barrier(bar);
#endif
    { const Params q = load_params(); if (q.bar == nullptr) grid.sync(); }
    STAGE(8, 0)
    if (PROBE == 1) { SYNC() STAGE(8, 0) }
    SYNC()
    STAGE(0, 0)
#define DUP(n, S, l) if (PROBE == n) { SYNC() STAGE(S, l) }
#define LAYER_REST(l) DUP(2, 0, l) SYNC() STAGE(1, l) if (PROBE >= 3 && PROBE <= 5) { SYNC() STAGE(9, l) } if (PROBE == 12) { SYNC() STAGE(12, l) } SYNC() STAGE(2, l) SYNC() STAGE(10, l) if (PROBE == 8) { SYNC() STAGE(2, l) SYNC() STAGE(10, l) } \
    SYNC() STAGE(3, l) DUP(9, 3, l) SYNC() STAGE(14, l) SYNC() STAGE(4, l) SYNC() STAGE(5, l) DUP(6, 5, l) SYNC() STAGE(6, l) DUP(7, 6, l) SYNC() STAGE(7, l)
    LAYER_REST(0)
    SYNC() STAGE(0, 1)
    LAYER_REST(1)
#undef LAYER_REST
#undef SYNC
#undef STAGE
}
#else
template <int S>
__global__ void __launch_bounds__(512, 2) k_one(Params p, int l) {
    extern __shared__ __attribute__((aligned(16))) char shm[];
    run_stage<S>(p, l, shm);
}
template <int S> static void launch_one(const Params& p, int l, hipStream_t stream) {
    (void)hipFuncSetAttribute((const void*)k_one<S>, hipFuncAttributeMaxDynamicSharedMemorySize, LDS_BYTES);
    hipLaunchKernelGGL(k_one<S>, dim3(256), dim3(512), LDS_BYTES, stream, p, l);
}
#endif

extern "C" void kernel_launch(void* const* d_in, const int* in_sizes, int n_in, void* d_out, int out_size, void* d_ws, size_t ws_size, hipStream_t stream) {
    Params p{};
    const float* const* in = (const float* const*)d_in;
    p.x_prompt = in[0]; p.x_sample = in[1]; p.cache_k = in[2]; p.cache_v = in[3]; p.cache_logf = in[4]; p.state_gla = in[5]; p.g_mix_pre = in[6]; p.w_in = in[7];
    p.w_gate_up = in[8]; p.b_gate = in[9]; p.b_fox_f = in[10]; p.g_onorm = in[11]; p.w_out = in[12]; p.g_mix_post = in[13]; p.g_mlp_pre = in[14]; p.w_up = in[15];
    p.w_down = in[16]; p.g_mlp_post = in[17];
    p.out = (float*)d_out;
    char* w = (char*)d_ws; size_t off = 0;
    auto take = [&](size_t bytes) { char* r = w + off; off += (bytes + 255) & ~(size_t)255; return r; };
    p.ctr = (unsigned*)take(256);
    p.bar = (unsigned*)take((size_t)XCD_BAR_WORDS * 4);
    p.WinT = (bf16_t*)take((size_t)2 * NIN * DM * 2); p.WoutT = (bf16_t*)take((size_t)2 * DM * DM * 2);
    p.WupT = (bf16_t*)take((size_t)2 * DFF * DM * 2); p.WdownT = (bf16_t*)take((size_t)2 * DM * DFF * 2);
    p.H = (bf16_t*)take((size_t)MT * DM * 2); p.MRG = (bf16_t*)take((size_t)MT * DM * 2); p.Z = (bf16_t*)take((size_t)MT * NZ * 2);
    p.U = (bf16_t*)take((size_t)MT * DFF * 2);
    p.EX = (float*)take((size_t)MT * 32 * 4); p.RAW = (bf16_t*)take((size_t)MT * DM * 2); p.YB = (bf16_t*)take((size_t)MT * DM * 2); p.OG = (float*)take((size_t)MT * 1024 * 4); p.DEC = (float*)take((size_t)544 * 128 * 4); p.PART = (float*)take((size_t)SPLIT_DOWN * 256 * DM * 4);
    p.FSO = (float*)take((size_t)256 * 32 * 128 * 4); p.FSML = (float*)take((size_t)256 * 32 * 2 * 4);
    p.KVT = (float*)p.U; p.SS = (bf16_t*)((char*)p.U + (size_t)544 * 32768 * 4); p.QI = (bf16_t*)((char*)p.U + (size_t)544 * 32768 * 6);
    if (off > ws_size) { fprintf(stderr, "workspace too small: need %zu have %zu\n", off, ws_size); return; }
#if MEGA
    static int grid_blocks = 0;
    if (!grid_blocks) {
        (void)hipFuncSetAttribute((const void*)k_mega, hipFuncAttributeMaxDynamicSharedMemorySize, LDS_BYTES);
        int dev = 0, cus = 0, per_cu = 0; hipGetDevice(&dev); hipDeviceGetAttribute(&cus, hipDeviceAttributeMultiprocessorCount, dev);
        hipOccupancyMaxActiveBlocksPerMultiprocessor(&per_cu, k_mega, 512, LDS_BYTES);
        if (per_cu < 1) per_cu = 1;
        grid_blocks = cus;
    }
    (void)hipMemsetAsync(p.bar, 0, (size_t)XCD_BAR_WORDS * 4, stream);
    void* args[] = {&p};
    hipError_t e = hipLaunchCooperativeKernel((void*)k_mega, dim3(grid_blocks), dim3(512), args, LDS_BYTES, stream);
    if (e != hipSuccess) fprintf(stderr, "cooperative launch failed: %s (grid %d)\n", hipGetErrorString(e), grid_blocks);
#else
    launch_one<8>(p, 0, stream);
    for (int l = 0; l < 2; ++l) { launch_one<0>(p, l, stream); launch_one<1>(p, l, stream); launch_one<2>(p, l, stream); launch_one<10>(p, l, stream); launch_one<3>(p, l, stream);
        launch_one<14>(p, l, stream); launch_one<4>(p, l, stream); launch_one<5>(p, l, stream); launch_one<6>(p, l, stream); launch_one<7>(p, l, stream); }
#endif
}
```
